# Optimizing an MI355X kernel written in HIP

```python
import math
import jax, jax.numpy as jnp
from jax import lax
import numpy as np

D_MODEL = 1024
BATCH = 2
SEQ = 8192
DEPTH = 1

SSM_HEADS = 8
SSM_HEAD_DIM = 64
D_SSM = SSM_HEADS * SSM_HEAD_DIM
SSM_GROUPS = 2
SSM_STATE = 128
CONV_WIDTH = 4
CHUNK = 256
ATTN_HEADS = 8
ATTN_KV_HEADS = 2
ATTN_HEAD_DIM = 64
D_ATTN = ATTN_HEADS * ATTN_HEAD_DIM
IDX_HEADS = 8
IDX_DIM = 64
TOPK_MAX = 256
Q_BLOCK = 128
N_BUCKETS = 32
MAX_DISTANCE = 128
D_FF = 4 * D_MODEL
D_XBC = D_SSM + 2 * SSM_GROUPS * SSM_STATE
D_IN = (D_SSM + D_XBC + SSM_HEADS
        + D_ATTN + 2 * ATTN_KV_HEADS * ATTN_HEAD_DIM
        + IDX_HEADS * IDX_DIM + IDX_DIM + IDX_HEADS)
D_MIX = D_SSM + D_ATTN
EPS = 1e-6

kernel_name = 'hybrid_ssd_dsa_sandwich_adaln_layer'


def rms_norm(x, w):
    xf = x.astype(jnp.float32)
    y = xf * lax.rsqrt(jnp.mean(xf * xf, axis=-1, keepdims=True) + EPS)
    return (y * w.astype(jnp.float32)).astype(x.dtype)


def t5_bucket(dist):
    n = jnp.maximum(dist, 0)
    max_exact = N_BUCKETS // 2
    nf = jnp.maximum(n, 1).astype(jnp.float32)
    large = max_exact + (jnp.log(nf / max_exact) / math.log(MAX_DISTANCE / max_exact)
                         * (N_BUCKETS - max_exact)).astype(jnp.int32)
    large = jnp.minimum(large, N_BUCKETS - 1)
    return jnp.where(n < max_exact, n, large)


def causal_dwconv(u, w, b):
    ch = u.shape[-1]
    out = lax.conv_general_dilated(
        u, w[:, None, :].astype(u.dtype), window_strides=(1,),
        padding=((w.shape[0] - 1, 0),), dimension_numbers=('NWC', 'WIO', 'NWC'),
        feature_group_count=ch)
    return out + b


def ssd_scan(xh, dt, a, bm, cm, d_skip):
    bsz, t, h, p = xh.shape
    g, n = bm.shape[2], bm.shape[3]
    r = h // g
    lc = math.gcd(t, CHUNK)
    nc = t // lc
    xdt = (xh.astype(jnp.float32) * dt[..., None]).reshape(bsz, nc, lc, g, r, p)
    adt = (a * dt).reshape(bsz, nc, lc, h)
    a_cs = jnp.cumsum(adt, axis=2)
    bc = bm.astype(jnp.float32).reshape(bsz, nc, lc, g, n)
    cc = cm.astype(jnp.float32).reshape(bsz, nc, lc, g, n)
    causal = jnp.tril(jnp.ones((lc, lc), dtype=bool))
    seg = a_cs[:, :, :, None, :] - a_cs[:, :, None, :, :]
    lmat = jnp.exp(jnp.where(causal[None, None, :, :, None], seg, -jnp.inf))
    lmat = lmat.reshape(bsz, nc, lc, lc, g, r)
    cb = jnp.einsum('bclgn,bcsgn->bclsg', cc, bc)
    y_diag = jnp.einsum('bclsgr,bcsgrp->bclgrp', cb[..., None] * lmat, xdt)
    decay_states = jnp.exp(a_cs[:, :, -1:, :] - a_cs).reshape(bsz, nc, lc, g, r)
    states = jnp.einsum('bclgn,bclgrp->bcgrpn', bc, xdt * decay_states[..., None])
    chunk_decay = jnp.exp(a_cs[:, :, -1, :]).reshape(bsz, nc, g, r)

    def step(hs, inp):
        s_c, dec_c = inp
        return hs * dec_c[..., None, None] + s_c, hs

    h0 = jnp.zeros_like(states[:, 0])
    _, prev = lax.scan(step, h0, (jnp.moveaxis(states, 1, 0), jnp.moveaxis(chunk_decay, 1, 0)))
    prev = jnp.moveaxis(prev, 0, 1)
    y_off = jnp.einsum('bclgn,bcgrpn->bclgrp', cc, prev) * \
        jnp.exp(a_cs).reshape(bsz, nc, lc, g, r)[..., None]
    y = y_diag + y_off + xh.astype(jnp.float32).reshape(bsz, nc, lc, g, r, p) * \
        d_skip.astype(jnp.float32).reshape(g, r)[:, :, None]
    return y.reshape(bsz, t, h * p).astype(xh.dtype)


def dsa_attention(q, k, v, q_idx, k_idx, w_idx, rel_bias):
    bsz, t, hkv, r, dh = q.shape
    topk = min(TOPK_MAX, t // 4)
    nblk = t // Q_BLOCK
    spos = jnp.arange(t, dtype=jnp.int32)

    def to_blocks(arr):
        return jnp.moveaxis(arr.reshape(bsz, nblk, Q_BLOCK, *arr.shape[2:]), 1, 0)

    def block(inp):
        qb, qib, wb, t0 = inp
        tpos = t0 + jnp.arange(Q_BLOCK, dtype=jnp.int32)
        s = jax.nn.relu(jnp.einsum('bqhd,bsd->bqhs', qib, k_idx).astype(jnp.float32)
                        * (IDX_DIM ** -0.5))
        score = jnp.einsum('bqh,bqhs->bqs', wb.astype(jnp.float32) * (IDX_HEADS ** -0.5), s)
        score = jnp.where((spos[None, :] <= tpos[:, None])[None], score, -jnp.inf)
        _, idx = lax.top_k(score, topk)
        kg = jax.vmap(lambda kb, ib: kb[ib])(k, idx)
        vg = jax.vmap(lambda vb, ib: vb[ib])(v, idx)
        logits = jnp.einsum('bqgrd,bqkgd->bqgrk', qb, kg).astype(jnp.float32) * (dh ** -0.5)
        bias = rel_bias[t5_bucket(tpos[None, :, None] - idx)].astype(jnp.float32)
        bias = jnp.transpose(bias.reshape(bsz, Q_BLOCK, topk, hkv, r), (0, 1, 3, 4, 2))
        valid = (idx <= tpos[None, :, None])[:, :, None, None, :]
        p = jax.nn.softmax(jnp.where(valid, logits + bias, -jnp.inf), axis=-1)
        return jnp.einsum('bqgrk,bqkgd->bqgrd', p.astype(vg.dtype), vg)

    t0s = jnp.arange(nblk, dtype=jnp.int32) * Q_BLOCK
    out = lax.map(block, (to_blocks(q), to_blocks(q_idx), to_blocks(w_idx), t0s))
    return jnp.moveaxis(out, 0, 1).reshape(bsz, t, hkv * r * dh)


def setup_inputs(seed: int = 0) -> dict:
    key = jax.random.key(seed)
    ks = jax.random.split(key, 24)
    f32 = jnp.float32

    def nrm(k, shape, scale):
        return jax.random.normal(k, shape, f32) * scale

    def gain(k, shape):
        return 1.0 + 0.05 * jax.random.normal(k, shape, f32)

    dt0 = jnp.exp(jax.random.uniform(ks[9], (DEPTH, SSM_HEADS), f32,
                                     math.log(1e-3), math.log(1e-1)))
    return {
        'x': nrm(ks[0], (BATCH, SEQ, D_MODEL), 1.0),
        'c': nrm(ks[1], (BATCH, D_MODEL), 1.0),
        'w_ada': nrm(ks[2], (DEPTH, D_MODEL, 6 * D_MODEL), D_MODEL ** -0.5),
        'b_ada': nrm(ks[3], (DEPTH, 6 * D_MODEL), 0.02),
        'norm1_pre': gain(ks[4], (DEPTH, D_MODEL)),
        'norm1_post': gain(ks[5], (DEPTH, D_MODEL)),
        'w_in': nrm(ks[6], (DEPTH, D_MODEL, D_IN), D_MODEL ** -0.5),
        'conv_w': nrm(ks[7], (DEPTH, CONV_WIDTH, D_XBC), CONV_WIDTH ** -0.5),
        'conv_b': nrm(ks[8], (DEPTH, D_XBC), 0.02),
        'dt_bias': dt0 + jnp.log(-jnp.expm1(-dt0)),
        'a_log': jnp.log(jax.random.uniform(ks[10], (DEPTH, SSM_HEADS), f32, 1.0, 16.0)),
        'd_skip': gain(ks[11], (DEPTH, SSM_HEADS)),
        'ssm_norm': gain(ks[12], (DEPTH, D_SSM)),
        'rel_bias': nrm(ks[13], (N_BUCKETS, ATTN_HEADS), 0.5),
        'attn_norm': gain(ks[14], (DEPTH, D_ATTN)),
        'w_out': nrm(ks[15], (DEPTH, D_MIX, D_MODEL), D_MIX ** -0.5),
        'norm2_pre': gain(ks[16], (DEPTH, D_MODEL)),
        'norm2_post': gain(ks[17], (DEPTH, D_MODEL)),
        'w_mlp_in': nrm(ks[18], (DEPTH, D_MODEL, D_FF), D_MODEL ** -0.5),
        'w_mlp_out': nrm(ks[19], (DEPTH, D_FF, D_MODEL), D_FF ** -0.5),
    }


def reference(x, c, w_ada, b_ada, norm1_pre, norm1_post, w_in, conv_w, conv_b, dt_bias,
              a_log, d_skip, ssm_norm, rel_bias, attn_norm, w_out, norm2_pre, norm2_post,
              w_mlp_in, w_mlp_out):
    bsz, t, _ = x.shape
    gq = ATTN_HEADS // ATTN_KV_HEADS
    sizes = [D_SSM, D_XBC, SSM_HEADS, D_ATTN, ATTN_KV_HEADS * ATTN_HEAD_DIM,
             ATTN_KV_HEADS * ATTN_HEAD_DIM, IDX_HEADS * IDX_DIM, IDX_DIM, IDX_HEADS]
    points = np.cumsum(sizes)[:-1].tolist()
    for l in range(DEPTH):
        mod = jax.nn.silu(c) @ w_ada[l] + b_ada[l]
        shift1, scale1, gate1, shift2, scale2, gate2 = [m[:, None, :] for m in jnp.split(mod, 6, axis=-1)]

        h = rms_norm(x, norm1_pre[l]) * (1.0 + scale1) + shift1
        proj = h @ w_in[l]
        z, xbc, dt_raw, q, k, v, q_idx, k_idx, w_idx = jnp.split(proj, points, axis=-1)

        xbc = jax.nn.silu(causal_dwconv(xbc, conv_w[l], conv_b[l]))
        xs, bm, cm = jnp.split(xbc, [D_SSM, D_SSM + SSM_GROUPS * SSM_STATE], axis=-1)
        dt = jax.nn.softplus(dt_raw.astype(jnp.float32) + dt_bias[l].astype(jnp.float32))
        a = -jnp.exp(a_log[l].astype(jnp.float32))
        y_ssd = ssd_scan(xs.reshape(bsz, t, SSM_HEADS, SSM_HEAD_DIM), dt, a,
                         bm.reshape(bsz, t, SSM_GROUPS, SSM_STATE),
                         cm.reshape(bsz, t, SSM_GROUPS, SSM_STATE), d_skip[l])
        y_ssd = rms_norm(y_ssd * jax.nn.silu(z), ssm_norm[l])

        y_att = dsa_attention(
            q.reshape(bsz, t, ATTN_KV_HEADS, gq, ATTN_HEAD_DIM),
            k.reshape(bsz, t, ATTN_KV_HEADS, ATTN_HEAD_DIM),
            v.reshape(bsz, t, ATTN_KV_HEADS, ATTN_HEAD_DIM),
            q_idx.reshape(bsz, t, IDX_HEADS, IDX_DIM), k_idx, w_idx, rel_bias)
        y_att = rms_norm(y_att, attn_norm[l])

        mix = jnp.concatenate([y_ssd, y_att], axis=-1) @ w_out[l]
        x = x + gate1 * rms_norm(mix, norm1_post[l])

        h = rms_norm(x, norm2_pre[l]) * (1.0 + scale2) + shift2
        f = jnp.square(jax.nn.relu(h @ w_mlp_in[l])) @ w_mlp_out[l]
        x = x + gate2 * rms_norm(f, norm2_post[l])
    return x
```

```cpp
#include <hip/hip_runtime.h>
#include <cstdio>
#include <cstdint>

typedef _Float16 h16;
typedef _Float16 h16x4 __attribute__((ext_vector_type(4)));
typedef _Float16 h16x8 __attribute__((ext_vector_type(8)));
typedef float f32x4 __attribute__((ext_vector_type(4)));

constexpr int NB = 2, T = 8192, D = 1024, M = NB * T, FF = 4096;
constexpr int NPROJ = 3072;
constexpr int C_Z = 0, C_XBC = 512, C_Q = 1536, C_K = 2048, C_V = 2176, C_QI = 2304, C_KI = 2816, C_DT = 2880, C_WI = 2888, C_END = 2896;
constexpr float EPS = 1e-6f;
constexpr int TOPK = 256;

constexpr size_t MiB = 1u << 20;
constexpr size_t WS_CTL = 0, WS_MOD = 1 * MiB, WS_PF32 = 2 * MiB;
constexpr size_t WS_WIN = 4 * MiB, WS_WOUT = 10 * MiB, WS_W1 = 12 * MiB, WS_W2 = 20 * MiB;
constexpr size_t WS_XN = 28 * MiB, WS_PROJ = 60 * MiB;
constexpr size_t WS_STATES = 156 * MiB, WS_PREV = 172 * MiB, WS_DT = 180 * MiB, WS_ACS = WS_DT + 512 * 1024;
constexpr size_t WS_MIX = 181 * MiB, WS_IDX = 213 * MiB, WS_YTMP = 221 * MiB;
constexpr size_t WS_MIXO = 60 * MiB, WS_H = 60 * MiB, WS_F = 188 * MiB;
constexpr size_t DO_XC = 0, DO_XST = 32 * MiB, DO_BT = 48 * MiB;

__device__ __forceinline__ float silu_f(float x) { return x / (1.f + __expf(-x)); }
__device__ __forceinline__ float softplus_f(float x) { return fmaxf(x, 0.f) + log1pf(__expf(-fabsf(x))); }
__device__ __forceinline__ float wave_sum(float v) {
#pragma unroll
    for (int o = 1; o < 64; o <<= 1) v += __shfl_xor(v, o);
    return v;
}
__device__ __forceinline__ int win_src(int n) {
    if (n < C_Q) return n;
    if (n < C_DT) return n + 8;
    if (n < C_WI) return n - C_DT + 1536;
    if (n < C_END) return n;
    return -1;
}
__device__ __forceinline__ int t5_bucket(int n) {
    if (n < 16) return n;
    int b = 16;
    b += (n >= 19); b += (n >= 21); b += (n >= 24); b += (n >= 27); b += (n >= 31); b += (n >= 35); b += (n >= 40); b += (n >= 46);
    b += (n >= 52); b += (n >= 59); b += (n >= 67); b += (n >= 77); b += (n >= 87); b += (n >= 99); b += (n >= 113);
    return b;
}
__device__ __forceinline__ unsigned fkey(float f) { unsigned u = __float_as_uint(f); return (u & 0x80000000u) ? ~u : (u | 0x80000000u); }

namespace nv {
__global__ void prep_w(const float* W, int K, int N, h16* WT, int NT, int mode) {
    const size_t i = (size_t)blockIdx.x * blockDim.x + threadIdx.x; if (i >= (size_t)NT * K) return;
    const int n = (int)(i / K), k = (int)(i % K); const int s = mode ? win_src(n) : n;
    WT[i] = (h16)(s < 0 ? 0.f : W[(size_t)k * N + s]);
}
__global__ void modk(const float* c, const float* w_ada, const float* b_ada, float* mod) {
    const int j = blockIdx.x * blockDim.x + threadIdx.x; if (j >= NB * 6 * D) return;
    const int b = j / (6 * D), jj = j % (6 * D); float acc = b_ada[jj];
    for (int k = 0; k < D; ++k) acc += silu_f(c[b * D + k]) * w_ada[(size_t)k * 6 * D + jj];
    mod[j] = acc;
}
__global__ void norm_mod(const float* x, const float* g, const float* mod, int ci, h16* xn) {
    const int m = blockIdx.x * (blockDim.x / 64) + (threadIdx.x >> 6), lane = threadIdx.x & 63; if (m >= M) return;
    const int b = m / T; const float* xr = x + (size_t)m * D; float v[16]; float ss = 0.f;
#pragma unroll
    for (int j = 0; j < 16; ++j) { v[j] = xr[lane + 64 * j]; ss += v[j] * v[j]; }
    const float rstd = rsqrtf(wave_sum(ss) * (1.f / D) + EPS);
    const float* sh = mod + (size_t)b * 6 * D + ci * D; const float* sc = sh + D;
#pragma unroll
    for (int j = 0; j < 16; ++j) { const int k = lane + 64 * j; xn[(size_t)m * D + k] = (h16)(v[j] * rstd * g[k] * (1.f + sc[k]) + sh[k]); }
}
struct EpiProj { h16* proj; float* pf32;
    __device__ void operator()(int m, int n, float v) const { proj[(size_t)m * NPROJ + n] = (h16)v; if (n >= C_DT && n < C_END) pf32[(size_t)m * 16 + (n - C_DT)] = v; } };
struct EpiF32 { float* C; int ldc; __device__ void operator()(int m, int n, float v) const { C[(size_t)m * ldc + n] = v; } };
struct EpiRelu2 { h16* C; int ldc; __device__ void operator()(int m, int n, float v) const { const float r = fmaxf(v, 0.f); C[(size_t)m * ldc + n] = (h16)(r * r); } };
template <class Epi> __global__ void __launch_bounds__(256) gemm(const h16* A, const h16* Bt, int Mm, int N, int K, Epi epi) {
    __shared__ float As[16][65], Bs[16][65];
    const int tid = threadIdx.x, tx = tid & 15, ty = tid >> 4, m0 = blockIdx.y * 64, n0 = blockIdx.x * 64;
    float acc[4][4] = {};
    const int lr = tid >> 2, lk = (tid & 3) * 4;
    for (int k0 = 0; k0 < K; k0 += 16) {
        const h16x4 a = *(const h16x4*)(A + (size_t)(m0 + lr) * K + k0 + lk), b = *(const h16x4*)(Bt + (size_t)(n0 + lr) * K + k0 + lk);
#pragma unroll
        for (int j = 0; j < 4; ++j) { As[lk + j][lr] = (float)a[j]; Bs[lk + j][lr] = (float)b[j]; }
        __syncthreads();
#pragma unroll
        for (int k = 0; k < 16; ++k) { float av[4], bv[4];
#pragma unroll
            for (int i = 0; i < 4; ++i) { av[i] = As[k][ty * 4 + i]; bv[i] = Bs[k][tx * 4 + i]; }
#pragma unroll
            for (int i = 0; i < 4; ++i)
#pragma unroll
                for (int j = 0; j < 4; ++j) acc[i][j] += av[i] * bv[j]; }
        __syncthreads();
    }
#pragma unroll
    for (int i = 0; i < 4; ++i)
#pragma unroll
        for (int j = 0; j < 4; ++j) epi(m0 + ty * 4 + i, n0 + tx * 4 + j, acc[i][j]);
}
__global__ void conv(const h16* proj, const float* pf32, const float* cw, const float* cb, const float* dt_bias, h16* xc, float* dtv) {
    const size_t i = (size_t)blockIdx.x * blockDim.x + threadIdx.x; if (i >= (size_t)M * 1024) return;
    const int m = (int)(i >> 10), ch = (int)(i & 1023), t = m % T; float acc = cb[ch];
#pragma unroll
    for (int w = 0; w < 4; ++w) { const int tt = t - 3 + w; if (tt >= 0) acc += cw[w * 1024 + ch] * (float)proj[(size_t)(m - 3 + w) * NPROJ + C_XBC + ch]; }
    xc[i] = (h16)silu_f(acc);
    if (ch < 8) dtv[(size_t)m * 8 + ch] = softplus_f(pf32[(size_t)m * 16 + ch] + dt_bias[ch]);
}
__global__ void __launch_bounds__(64) ssd_rec(const h16* xc, const float* dtv, const float* a_log, const float* d_skip, float* y) {
    const int b = blockIdx.x / 8, h = blockIdx.x % 8, g = h / 4, p = threadIdx.x;
    const float a = -__expf(a_log[h]), dsk = d_skip[h]; float st[128];
#pragma unroll
    for (int n = 0; n < 128; ++n) st[n] = 0.f;
    for (int t = 0; t < T; ++t) {
        const size_t m = (size_t)b * T + t; const float dt = dtv[m * 8 + h], dA = __expf(a * dt), xs = (float)xc[m * 1024 + h * 64 + p], xdt = xs * dt;
        const h16* Bp = xc + m * 1024 + 512 + g * 128; const h16* Cp = xc + m * 1024 + 768 + g * 128; float acc = 0.f;
#pragma unroll
        for (int n = 0; n < 128; ++n) { st[n] = st[n] * dA + (float)Bp[n] * xdt; acc += (float)Cp[n] * st[n]; }
        y[m * 512 + h * 64 + p] = acc + dsk * xs;
    }
}
__global__ void norm512(const float* y, const h16* proj, int gate, const float* w, h16* mix, int coff) {
    const int m = blockIdx.x * (blockDim.x / 64) + (threadIdx.x >> 6), lane = threadIdx.x & 63; if (m >= M) return;
    float v[8]; float ss = 0.f;
#pragma unroll
    for (int j = 0; j < 8; ++j) { const int k = lane + 64 * j; float u = y[(size_t)m * 512 + k]; if (gate) u *= silu_f((float)proj[(size_t)m * NPROJ + C_Z + k]); v[j] = u; ss += u * u; }
    const float rstd = rsqrtf(wave_sum(ss) * (1.f / 512.f) + EPS);
#pragma unroll
    for (int j = 0; j < 8; ++j) { const int k = lane + 64 * j; mix[(size_t)m * D + coff + k] = (h16)(v[j] * rstd * w[k]); }
}
__global__ void __launch_bounds__(256) scores(const h16* proj, const float* pf32, int q0, float* slab) {
    __shared__ float qs[512]; __shared__ float ws[8];
    const int ql = blockIdx.y, m = q0 + ql, t = m % T, b = m / T, s = blockIdx.x * 256 + threadIdx.x;
    if (blockIdx.x * 256 > t) return;
    for (int i = threadIdx.x; i < 512; i += 256) qs[i] = (float)proj[(size_t)m * NPROJ + C_QI + i];
    if (threadIdx.x < 8) ws[threadIdx.x] = pf32[(size_t)m * 16 + 8 + threadIdx.x] * 0.35355339059327373f * 0.125f;
    __syncthreads();
    float kv[64]; const h16* kp = proj + (size_t)(b * T + s) * NPROJ + C_KI;
#pragma unroll
    for (int d = 0; d < 64; ++d) kv[d] = (float)kp[d];
    float sc = 0.f;
    for (int h = 0; h < 8; ++h) { float dot = 0.f;
#pragma unroll
        for (int d = 0; d < 64; ++d) dot += qs[h * 64 + d] * kv[d];
        sc += ws[h] * fmaxf(dot, 0.f); }
    slab[(size_t)ql * T + s] = sc;
}
__global__ void __launch_bounds__(256) select(const float* slab, int q0, unsigned short* idx) {
    __shared__ unsigned red[256]; __shared__ unsigned sh_cnt;
    const int ql = blockIdx.x, m = q0 + ql, t = m % T, n = t + 1, tid = threadIdx.x;
    unsigned short* out = idx + (size_t)m * TOPK;
    if (n <= TOPK) { out[tid] = (unsigned short)(tid < n ? tid : 0); return; }
    unsigned key[32];
#pragma unroll
    for (int j = 0; j < 32; ++j) { const int i = tid * 32 + j; key[j] = i < n ? fkey(slab[(size_t)ql * T + i]) : 0u; }
    unsigned Kt = 0u;
    for (int bit = 31; bit >= 0; --bit) {
        const unsigned cand = Kt | (1u << bit); unsigned c = 0;
#pragma unroll
        for (int j = 0; j < 32; ++j) c += (key[j] >= cand);
        if (tid == 0) sh_cnt = 0u; __syncthreads();
        atomicAdd(&sh_cnt, c); __syncthreads();
        if (sh_cnt >= (unsigned)TOPK) Kt = cand;
        __syncthreads();
    }
    unsigned cg = 0, ce = 0;
#pragma unroll
    for (int j = 0; j < 32; ++j) { cg += (key[j] > Kt); ce += (key[j] == Kt); }
    red[tid] = (cg << 16) | ce; __syncthreads();
    unsigned pg = 0, pe = 0, tg = 0;
    for (int i = 0; i < 256; ++i) { const unsigned r = red[i]; if (i < tid) { pg += r >> 16; pe += r & 0xffffu; } tg += r >> 16; }
    const unsigned need = (unsigned)TOPK - tg;
    unsigned sel_before = pg + (pe < need ? pe : need);
#pragma unroll
    for (int j = 0; j < 32; ++j) {
        bool s = false;
        if (key[j] > Kt) s = true; else if (key[j] == Kt) { s = pe < need; ++pe; }
        if (s) { out[sel_before] = (unsigned short)(tid * 32 + j); ++sel_before; }
    }
}
__global__ void __launch_bounds__(256) attn(const h16* proj, const unsigned short* idx, const float* rel_bias, float* y) {
    const int gid = blockIdx.x * 256 + threadIdx.x, m = gid >> 3, h = gid & 7, g = h >> 2, t = m % T, b = m / T;
    const int cnt = (t + 1 < TOPK) ? t + 1 : TOPK;
    float q[64], acc[64];
#pragma unroll
    for (int d = 0; d < 64; ++d) { q[d] = (float)proj[(size_t)m * NPROJ + C_Q + h * 64 + d] * 0.125f; acc[d] = 0.f; }
    float mx = -INFINITY, l = 0.f;
    for (int j = 0; j < cnt; ++j) {
        const int s = idx[(size_t)m * TOPK + j]; const h16* kp = proj + (size_t)(b * T + s) * NPROJ + C_K + g * 64; const h16* vp = kp + (C_V - C_K);
        float lg = rel_bias[t5_bucket(t - s) * 8 + h];
#pragma unroll
        for (int d = 0; d < 64; ++d) lg += q[d] * (float)kp[d];
        const float mn = fmaxf(mx, lg), sc = __expf(mx - mn), pe = __expf(lg - mn);
        l = l * sc + pe; mx = mn;
#pragma unroll
        for (int d = 0; d < 64; ++d) acc[d] = acc[d] * sc + pe * (float)vp[d];
    }
    const float inv = 1.f / l;
#pragma unroll
    for (int d = 0; d < 64; ++d) y[(size_t)m * 512 + h * 64 + d] = acc[d] * inv;
}
__global__ void post1(const float* x, const float* mixo, const float* mod, const float* w1post, const float* w2pre, float* out, h16* xn) {
    const int m = blockIdx.x * (blockDim.x / 64) + (threadIdx.x >> 6), lane = threadIdx.x & 63; if (m >= M) return;
    const int b = m / T; const float* md = mod + (size_t)b * 6 * D; float v[16]; float ss = 0.f;
#pragma unroll
    for (int j = 0; j < 16; ++j) { v[j] = mixo[(size_t)m * D + lane + 64 * j]; ss += v[j] * v[j]; }
    float rstd = rsqrtf(wave_sum(ss) * (1.f / D) + EPS); ss = 0.f;
#pragma unroll
    for (int j = 0; j < 16; ++j) { const int k = lane + 64 * j; v[j] = x[(size_t)m * D + k] + md[2 * D + k] * (v[j] * rstd * w1post[k]); out[(size_t)m * D + k] = v[j]; ss += v[j] * v[j]; }
    rstd = rsqrtf(wave_sum(ss) * (1.f / D) + EPS);
#pragma unroll
    for (int j = 0; j < 16; ++j) { const int k = lane + 64 * j; xn[(size_t)m * D + k] = (h16)(v[j] * rstd * w2pre[k] * (1.f + md[4 * D + k]) + md[3 * D + k]); }
}
__global__ void post2(const float* f, const float* mod, const float* w2post, float* out) {
    const int m = blockIdx.x * (blockDim.x / 64) + (threadIdx.x >> 6), lane = threadIdx.x & 63; if (m >= M) return;
    const int b = m / T; const float* md = mod + (size_t)b * 6 * D; float v[16]; float ss = 0.f;
#pragma unroll
    for (int j = 0; j < 16; ++j) { v[j] = f[(size_t)m * D + lane + 64 * j]; ss += v[j] * v[j]; }
    const float rstd = rsqrtf(wave_sum(ss) * (1.f / D) + EPS);
#pragma unroll
    for (int j = 0; j < 16; ++j) { const int k = lane + 64 * j; out[(size_t)m * D + k] += md[5 * D + k] * (v[j] * rstd * w2post[k]); }
}
}

extern "C" void kernel_launch(void* const* d_in, const int* in_sizes, int n_in, void* d_out, int out_size, void* d_ws, size_t ws_size, hipStream_t stream) {
    const float* x = (const float*)d_in[0]; const float* c = (const float*)d_in[1]; const float* w_ada = (const float*)d_in[2]; const float* b_ada = (const float*)d_in[3];
    const float* norm1_pre = (const float*)d_in[4]; const float* norm1_post = (const float*)d_in[5]; const float* w_in = (const float*)d_in[6];
    const float* conv_w = (const float*)d_in[7]; const float* conv_b = (const float*)d_in[8]; const float* dt_bias = (const float*)d_in[9];
    const float* a_log = (const float*)d_in[10]; const float* d_skip = (const float*)d_in[11]; const float* ssm_norm = (const float*)d_in[12];
    const float* rel_bias = (const float*)d_in[13]; const float* attn_norm = (const float*)d_in[14]; const float* w_out = (const float*)d_in[15];
    const float* norm2_pre = (const float*)d_in[16]; const float* norm2_post = (const float*)d_in[17]; const float* w_mlp_in = (const float*)d_in[18]; const float* w_mlp_out = (const float*)d_in[19];
    unsigned char* ws = (unsigned char*)d_ws; unsigned char* dob = (unsigned char*)d_out; float* out = (float*)d_out;
    float* MOD = (float*)(ws + WS_MOD); float* PF32 = (float*)(ws + WS_PF32);
    h16* WIN = (h16*)(ws + WS_WIN); h16* WOUT = (h16*)(ws + WS_WOUT); h16* W1 = (h16*)(ws + WS_W1); h16* W2 = (h16*)(ws + WS_W2);
    h16* XN = (h16*)(ws + WS_XN); h16* PROJ = (h16*)(ws + WS_PROJ); h16* MIX = (h16*)(ws + WS_MIX); unsigned short* IDX = (unsigned short*)(ws + WS_IDX);
    float* YTMP = (float*)(ws + WS_YTMP); float* DTV = (float*)(ws + WS_DT); float* MIXO = (float*)(ws + WS_MIXO); h16* HB = (h16*)(ws + WS_H); float* FB = (float*)(ws + WS_F);
    h16* XC = (h16*)(dob + DO_XC); float* SLAB = (float*)dob;

    nv::prep_w<<<(NPROJ * D + 255) / 256, 256, 0, stream>>>(w_in, D, 2896, WIN, NPROJ, 1);
    nv::prep_w<<<(D * D + 255) / 256, 256, 0, stream>>>(w_out, D, D, WOUT, D, 0);
    nv::prep_w<<<(FF * D + 255) / 256, 256, 0, stream>>>(w_mlp_in, D, FF, W1, FF, 0);
    nv::prep_w<<<(D * FF + 255) / 256, 256, 0, stream>>>(w_mlp_out, FF, D, W2, D, 0);
    nv::modk<<<(NB * 6 * D + 255) / 256, 256, 0, stream>>>(c, w_ada, b_ada, MOD);
    nv::norm_mod<<<M / 4, 256, 0, stream>>>(x, norm1_pre, MOD, 0, XN);
    nv::gemm<nv::EpiProj><<<dim3(NPROJ / 64, M / 64), 256, 0, stream>>>(XN, WIN, M, NPROJ, D, nv::EpiProj{PROJ, PF32});
    nv::conv<<<(M * 1024) / 256, 256, 0, stream>>>(PROJ, PF32, conv_w, conv_b, dt_bias, XC, DTV);
    nv::ssd_rec<<<NB * 8, 64, 0, stream>>>(XC, DTV, a_log, d_skip, YTMP);
    nv::norm512<<<M / 4, 256, 0, stream>>>(YTMP, PROJ, 1, ssm_norm, MIX, 0);
    for (int q0 = 0; q0 < M; q0 += 1024) {
        nv::scores<<<dim3(T / 256, 1024), 256, 0, stream>>>(PROJ, PF32, q0, SLAB);
        nv::select<<<1024, 256, 0, stream>>>(SLAB, q0, IDX);
    }
    nv::attn<<<M * 8 / 256, 256, 0, stream>>>(PROJ, IDX, rel_bias, YTMP);
    nv::norm512<<<M / 4, 256, 0, stream>>>(YTMP, PROJ, 0, attn_norm, MIX, 512);
    nv::gemm<nv::EpiF32><<<dim3(D / 64, M / 64), 256, 0, stream>>>(MIX, WOUT, M, D, D, nv::EpiF32{MIXO, D});
    nv::post1<<<M / 4, 256, 0, stream>>>(x, MIXO, MOD, norm1_post, norm2_pre, out, XN);
    nv::gemm<nv::EpiRelu2><<<dim3(FF / 64, M / 64), 256, 0, stream>>>(XN, W1, M, FF, D, nv::EpiRelu2{HB, FF});
    nv::gemm<nv::EpiF32><<<dim3(D / 64, M / 64), 256, 0, stream>>>(HB, W2, M, D, FF, nv::EpiF32{FB, D});
    nv::post2<<<M / 4, 256, 0, stream>>>(FB, MOD, norm2_post, out);
}
```

```cpp
#include <hip/hip_runtime.h>
#include <cstdio>
#include <cstdint>

typedef _Float16 h16;
typedef _Float16 h16x4 __attribute__((ext_vector_type(4)));
typedef _Float16 h16x8 __attribute__((ext_vector_type(8)));
typedef float f32x4 __attribute__((ext_vector_type(4)));

constexpr int NB = 2, T = 8192, D = 1024, M = NB * T, FF = 4096;
constexpr int NPROJ = 3072;
constexpr int C_Z = 0, C_XBC = 512, C_Q = 1536, C_K = 2048, C_V = 2176, C_QI = 2304, C_KI = 2816, C_DT = 2880, C_WI = 2888, C_END = 2896;
constexpr float EPS = 1e-6f;
constexpr int TOPK = 256;

constexpr size_t MiB = 1u << 20;
constexpr size_t WS_CTL = 0, WS_MOD = 1 * MiB, WS_PF32 = 2 * MiB;
constexpr size_t WS_WIN = 4 * MiB, WS_WOUT = 10 * MiB, WS_W1 = 12 * MiB, WS_W2 = 20 * MiB;
constexpr size_t WS_XN = 28 * MiB, WS_PROJ = 60 * MiB;
constexpr size_t WS_STATES = 156 * MiB, WS_PREV = 172 * MiB, WS_DT = 180 * MiB, WS_ACS = WS_DT + 512 * 1024;
constexpr size_t WS_MIX = 181 * MiB, WS_IDX = 213 * MiB, WS_YTMP = 221 * MiB;
constexpr size_t WS_MIXO = 60 * MiB, WS_H = 60 * MiB, WS_F = 188 * MiB;
constexpr size_t DO_XC = 0, DO_XST = 32 * MiB, DO_BT = 48 * MiB;

__device__ __forceinline__ float silu_f(float x) { return x / (1.f + __expf(-x)); }
__device__ __forceinline__ float softplus_f(float x) { return fmaxf(x, 0.f) + log1pf(__expf(-fabsf(x))); }
__device__ __forceinline__ float wave_sum(float v) {
#pragma unroll
    for (int o = 1; o < 64; o <<= 1) v += __shfl_xor(v, o);
    return v;
}
__device__ __forceinline__ int win_src(int n) {
    if (n < C_Q) return n;
    if (n < C_DT) return n + 8;
    if (n < C_WI) return n - C_DT + 1536;
    if (n < C_END) return n;
    return -1;
}
__device__ __forceinline__ int t5_bucket(int n) {
    if (n < 16) return n;
    int b = 16;
    b += (n >= 19); b += (n >= 21); b += (n >= 24); b += (n >= 27); b += (n >= 31); b += (n >= 35); b += (n >= 40); b += (n >= 46);
    b += (n >= 52); b += (n >= 59); b += (n >= 67); b += (n >= 77); b += (n >= 87); b += (n >= 99); b += (n >= 113);
    return b;
}
__device__ __forceinline__ unsigned fkey(float f) { unsigned u = __float_as_uint(f); return (u & 0x80000000u) ? ~u : (u | 0x80000000u); }

namespace nv {
__global__ void prep_w(const float* W, int K, int N, h16* WT, int NT, int mode) {
    const size_t i = (size_t)blockIdx.x * blockDim.x + threadIdx.x; if (i >= (size_t)NT * K) return;
    const int n = (int)(i / K), k = (int)(i % K); const int s = mode ? win_src(n) : n;
    WT[i] = (h16)(s < 0 ? 0.f : W[(size_t)k * N + s]);
}
__global__ void modk(const float* c, const float* w_ada, const float* b_ada, float* mod) {
    const int j = blockIdx.x * blockDim.x + threadIdx.x; if (j >= NB * 6 * D) return;
    const int b = j / (6 * D), jj = j % (6 * D); float acc = b_ada[jj];
    for (int k = 0; k < D; ++k) acc += silu_f(c[b * D + k]) * w_ada[(size_t)k * 6 * D + jj];
    mod[j] = acc;
}
__global__ void norm_mod(const float* x, const float* g, const float* mod, int ci, h16* xn) {
    const int m = blockIdx.x * (blockDim.x / 64) + (threadIdx.x >> 6), lane = threadIdx.x & 63; if (m >= M) return;
    const int b = m / T; const float* xr = x + (size_t)m * D; float v[16]; float ss = 0.f;
#pragma unroll
    for (int j = 0; j < 16; ++j) { v[j] = xr[lane + 64 * j]; ss += v[j] * v[j]; }
    const float rstd = rsqrtf(wave_sum(ss) * (1.f / D) + EPS);
    const float* sh = mod + (size_t)b * 6 * D + ci * D; const float* sc = sh + D;
#pragma unroll
    for (int j = 0; j < 16; ++j) { const int k = lane + 64 * j; xn[(size_t)m * D + k] = (h16)(v[j] * rstd * g[k] * (1.f + sc[k]) + sh[k]); }
}
struct EpiProj { h16* proj; float* pf32;
    __device__ void operator()(int m, int n, float v) const { proj[(size_t)m * NPROJ + n] = (h16)v; if (n >= C_DT && n < C_END) pf32[(size_t)m * 16 + (n - C_DT)] = v; } };
struct EpiF32 { float* C; int ldc; __device__ void operator()(int m, int n, float v) const { C[(size_t)m * ldc + n] = v; } };
struct EpiRelu2 { h16* C; int ldc; __device__ void operator()(int m, int n, float v) const { const float r = fmaxf(v, 0.f); C[(size_t)m * ldc + n] = (h16)(r * r); } };
template <class Epi> __global__ void __launch_bounds__(256) gemm(const h16* A, const h16* Bt, int Mm, int N, int K, Epi epi) {
    __shared__ float As[16][65], Bs[16][65];
    const int tid = threadIdx.x, tx = tid & 15, ty = tid >> 4, m0 = blockIdx.y * 64, n0 = blockIdx.x * 64;
    float acc[4][4] = {};
    const int lr = tid >> 2, lk = (tid & 3) * 4;
    for (int k0 = 0; k0 < K; k0 += 16) {
        const h16x4 a = *(const h16x4*)(A + (size_t)(m0 + lr) * K + k0 + lk), b = *(const h16x4*)(Bt + (size_t)(n0 + lr) * K + k0 + lk);
#pragma unroll
        for (int j = 0; j < 4; ++j) { As[lk + j][lr] = (float)a[j]; Bs[lk + j][lr] = (float)b[j]; }
        __syncthreads();
#pragma unroll
        for (int k = 0; k < 16; ++k) { float av[4], bv[4];
#pragma unroll
            for (int i = 0; i < 4; ++i) { av[i] = As[k][ty * 4 + i]; bv[i] = Bs[k][tx * 4 + i]; }
#pragma unroll
            for (int i = 0; i < 4; ++i)
#pragma unroll
                for (int j = 0; j < 4; ++j) acc[i][j] += av[i] * bv[j]; }
        __syncthreads();
    }
#pragma unroll
    for (int i = 0; i < 4; ++i)
#pragma unroll
        for (int j = 0; j < 4; ++j) epi(m0 + ty * 4 + i, n0 + tx * 4 + j, acc[i][j]);
}
__global__ void conv(const h16* proj, const float* pf32, const float* cw, const float* cb, const float* dt_bias, h16* xc, float* dtv) {
    const size_t i = (size_t)blockIdx.x * blockDim.x + threadIdx.x; if (i >= (size_t)M * 1024) return;
    const int m = (int)(i >> 10), ch = (int)(i & 1023), t = m % T; float acc = cb[ch];
#pragma unroll
    for (int w = 0; w < 4; ++w) { const int tt = t - 3 + w; if (tt >= 0) acc += cw[w * 1024 + ch] * (float)proj[(size_t)(m - 3 + w) * NPROJ + C_XBC + ch]; }
    xc[i] = (h16)silu_f(acc);
    if (ch < 8) dtv[(size_t)m * 8 + ch] = softplus_f(pf32[(size_t)m * 16 + ch] + dt_bias[ch]);
}
__global__ void __launch_bounds__(64) ssd_rec(const h16* xc, const float* dtv, const float* a_log, const float* d_skip, float* y) {
    const int b = blockIdx.x / 8, h = blockIdx.x % 8, g = h / 4, p = threadIdx.x;
    const float a = -__expf(a_log[h]), dsk = d_skip[h]; float st[128];
#pragma unroll
    for (int n = 0; n < 128; ++n) st[n] = 0.f;
    for (int t = 0; t < T; ++t) {
        const size_t m = (size_t)b * T + t; const float dt = dtv[m * 8 + h], dA = __expf(a * dt), xs = (float)xc[m * 1024 + h * 64 + p], xdt = xs * dt;
        const h16* Bp = xc + m * 1024 + 512 + g * 128; const h16* Cp = xc + m * 1024 + 768 + g * 128; float acc = 0.f;
#pragma unroll
        for (int n = 0; n < 128; ++n) { st[n] = st[n] * dA + (float)Bp[n] * xdt; acc += (float)Cp[n] * st[n]; }
        y[m * 512 + h * 64 + p] = acc + dsk * xs;
    }
}
__global__ void norm512(const float* y, const h16* proj, int gate, const float* w, h16* mix, int coff) {
    const int m = blockIdx.x * (blockDim.x / 64) + (threadIdx.x >> 6), lane = threadIdx.x & 63; if (m >= M) return;
    float v[8]; float ss = 0.f;
#pragma unroll
    for (int j = 0; j < 8; ++j) { const int k = lane + 64 * j; float u = y[(size_t)m * 512 + k]; if (gate) u *= silu_f((float)proj[(size_t)m * NPROJ + C_Z + k]); v[j] = u; ss += u * u; }
    const float rstd = rsqrtf(wave_sum(ss) * (1.f / 512.f) + EPS);
#pragma unroll
    for (int j = 0; j < 8; ++j) { const int k = lane + 64 * j; mix[(size_t)m * D + coff + k] = (h16)(v[j] * rstd * w[k]); }
}
__global__ void __launch_bounds__(256) scores(const h16* proj, const float* pf32, int q0, float* slab) {
    __shared__ float qs[512]; __shared__ float ws[8];
    const int ql = blockIdx.y, m = q0 + ql, t = m % T, b = m / T, s = blockIdx.x * 256 + threadIdx.x;
    if (blockIdx.x * 256 > t) return;
    for (int i = threadIdx.x; i < 512; i += 256) qs[i] = (float)proj[(size_t)m * NPROJ + C_QI + i];
    if (threadIdx.x < 8) ws[threadIdx.x] = pf32[(size_t)m * 16 + 8 + threadIdx.x] * 0.35355339059327373f * 0.125f;
    __syncthreads();
    float kv[64]; const h16* kp = proj + (size_t)(b * T + s) * NPROJ + C_KI;
#pragma unroll
    for (int d = 0; d < 64; ++d) kv[d] = (float)kp[d];
    float sc = 0.f;
    for (int h = 0; h < 8; ++h) { float dot = 0.f;
#pragma unroll
        for (int d = 0; d < 64; ++d) dot += qs[h * 64 + d] * kv[d];
        sc += ws[h] * fmaxf(dot, 0.f); }
    slab[(size_t)ql * T + s] = sc;
}
__global__ void __launch_bounds__(256) select(const float* slab, int q0, unsigned short* idx) {
    __shared__ unsigned red[256]; __shared__ unsigned sh_cnt;
    const int ql = blockIdx.x, m = q0 + ql, t = m % T, n = t + 1, tid = threadIdx.x;
    unsigned short* out = idx + (size_t)m * TOPK;
    if (n <= TOPK) { out[tid] = (unsigned short)(tid < n ? tid : 0); return; }
    unsigned key[32];
#pragma unroll
    for (int j = 0; j < 32; ++j) { const int i = tid * 32 + j; key[j] = i < n ? fkey(slab[(size_t)ql * T + i]) : 0u; }
    unsigned Kt = 0u;
    for (int bit = 31; bit >= 0; --bit) {
        const unsigned cand = Kt | (1u << bit); unsigned c = 0;
#pragma unroll
        for (int j = 0; j < 32; ++j) c += (key[j] >= cand);
        if (tid == 0) sh_cnt = 0u; __syncthreads();
        atomicAdd(&sh_cnt, c); __syncthreads();
        if (sh_cnt >= (unsigned)TOPK) Kt = cand;
        __syncthreads();
    }
    unsigned cg = 0, ce = 0;
#pragma unroll
    for (int j = 0; j < 32; ++j) { cg += (key[j] > Kt); ce += (key[j] == Kt); }
    red[tid] = (cg << 16) | ce; __syncthreads();
    unsigned pg = 0, pe = 0, tg = 0;
    for (int i = 0; i < 256; ++i) { const unsigned r = red[i]; if (i < tid) { pg += r >> 16; pe += r & 0xffffu; } tg += r >> 16; }
    const unsigned need = (unsigned)TOPK - tg;
    unsigned sel_before = pg + (pe < need ? pe : need);
#pragma unroll
    for (int j = 0; j < 32; ++j) {
        bool s = false;
        if (key[j] > Kt) s = true; else if (key[j] == Kt) { s = pe < need; ++pe; }
        if (s) { out[sel_before] = (unsigned short)(tid * 32 + j); ++sel_before; }
    }
}
__global__ void __launch_bounds__(256) attn(const h16* proj, const unsigned short* idx, const float* rel_bias, float* y) {
    const int gid = blockIdx.x * 256 + threadIdx.x, m = gid >> 3, h = gid & 7, g = h >> 2, t = m % T, b = m / T;
    const int cnt = (t + 1 < TOPK) ? t + 1 : TOPK;
    float q[64], acc[64];
#pragma unroll
    for (int d = 0; d < 64; ++d) { q[d] = (float)proj[(size_t)m * NPROJ + C_Q + h * 64 + d] * 0.125f; acc[d] = 0.f; }
    float mx = -INFINITY, l = 0.f;
    for (int j = 0; j < cnt; ++j) {
        const int s = idx[(size_t)m * TOPK + j]; const h16* kp = proj + (size_t)(b * T + s) * NPROJ + C_K + g * 64; const h16* vp = kp + (C_V - C_K);
        float lg = rel_bias[t5_bucket(t - s) * 8 + h];
#pragma unroll
        for (int d = 0; d < 64; ++d) lg += q[d] * (float)kp[d];
        const float mn = fmaxf(mx, lg), sc = __expf(mx - mn), pe = __expf(lg - mn);
        l = l * sc + pe; mx = mn;
#pragma unroll
        for (int d = 0; d < 64; ++d) acc[d] = acc[d] * sc + pe * (float)vp[d];
    }
    const float inv = 1.f / l;
#pragma unroll
    for (int d = 0; d < 64; ++d) y[(size_t)m * 512 + h * 64 + d] = acc[d] * inv;
}
__global__ void post1(const float* x, const float* mixo, const float* mod, const float* w1post, const float* w2pre, float* out, h16* xn) {
    const int m = blockIdx.x * (blockDim.x / 64) + (threadIdx.x >> 6), lane = threadIdx.x & 63; if (m >= M) return;
    const int b = m / T; const float* md = mod + (size_t)b * 6 * D; float v[16]; float ss = 0.f;
#pragma unroll
    for (int j = 0; j < 16; ++j) { v[j] = mixo[(size_t)m * D + lane + 64 * j]; ss += v[j] * v[j]; }
    float rstd = rsqrtf(wave_sum(ss) * (1.f / D) + EPS); ss = 0.f;
#pragma unroll
    for (int j = 0; j < 16; ++j) { const int k = lane + 64 * j; v[j] = x[(size_t)m * D + k] + md[2 * D + k] * (v[j] * rstd * w1post[k]); out[(size_t)m * D + k] = v[j]; ss += v[j] * v[j]; }
    rstd = rsqrtf(wave_sum(ss) * (1.f / D) + EPS);
#pragma unroll
    for (int j = 0; j < 16; ++j) { const int k = lane + 64 * j; xn[(size_t)m * D + k] = (h16)(v[j] * rstd * w2pre[k] * (1.f + md[4 * D + k]) + md[3 * D + k]); }
}
__global__ void post2(const float* f, const float* mod, const float* w2post, float* out) {
    const int m = blockIdx.x * (blockDim.x / 64) + (threadIdx.x >> 6), lane = threadIdx.x & 63; if (m >= M) return;
    const int b = m / T; const float* md = mod + (size_t)b * 6 * D; float v[16]; float ss = 0.f;
#pragma unroll
    for (int j = 0; j < 16; ++j) { v[j] = f[(size_t)m * D + lane + 64 * j]; ss += v[j] * v[j]; }
    const float rstd = rsqrtf(wave_sum(ss) * (1.f / D) + EPS);
#pragma unroll
    for (int j = 0; j < 16; ++j) { const int k = lane + 64 * j; out[(size_t)m * D + k] += md[5 * D + k] * (v[j] * rstd * w2post[k]); }
}
}


#define LAS __attribute__((address_space(3)))
#define GAS __attribute__((address_space(1)))
typedef unsigned u32x4 __attribute__((ext_vector_type(4)));
typedef unsigned u32x2 __attribute__((ext_vector_type(2)));
typedef float f32x2 __attribute__((ext_vector_type(2)));
typedef _Float16 h16x2 __attribute__((ext_vector_type(2)));
__device__ __forceinline__ unsigned pk_h2(float lo, float hi) { const f32x2 v = {lo, hi}; const h16x2 h = __builtin_convertvector(v, h16x2); return __builtin_bit_cast(unsigned, h); }

namespace pg8 {
constexpr int BM = 256, BK = 64, HALF = 128, HTB = HALF * BK * 2, STAGE_BYTES = 8 * HTB, NXCD = 8, WGM = 8;
__host__ __device__ __forceinline__ int lds_byte(int r, int c) { const int st = (r >> 4) * 2 + (c >> 5), rr = r & 15, cc = c & 31, ob = rr * 64 + cc * 2; return st * 1024 + (ob ^ (((ob >> 9) & 1) << 5)); }
__host__ __device__ __forceinline__ void stage_rc(int b, int& R, int& C) { const int st = b / 1024, sb = b % 1024, swz = sb ^ (((sb >> 9) & 1) << 5); R = (st >> 1) * 16 + swz / 64; C = (st & 1) * 32 + (swz % 64) / 2; }
__host__ __device__ __forceinline__ int perm32(int rho) { const int n = rho >> 4, i = rho & 15; return 8 * (i >> 2) + 4 * n + (i & 3); }
struct Unit { int pm, pn; };
struct Gemm { const h16* A; const h16* Bt; int M, N, K; };
struct StaticOrder {
    int nM, nN, nwg, G, c;
    __host__ __device__ void init(int M_, int N_, int G_, int c_) { nM = M_ / BM; nN = N_ / BM; nwg = nM * nN; G = G_; c = c_; }
    __host__ __device__ bool next(int i, Unit& u) const {
        const long L = (long)i * G + c; if (L >= nwg) return false;
        int wgid = (int)L; { const int q = nwg / NXCD, r = nwg % NXCD, xcd = wgid % NXCD, off = wgid / NXCD; wgid = (xcd < r ? xcd * (q + 1) : r * (q + 1) + (xcd - r) * q) + off; }
        const int nig = WGM * nN, gid = wgid / nig, fm = gid * WGM, gsz = (nM - fm) < WGM ? (nM - fm) : WGM;
        u.pm = fm + ((wgid % nig) % gsz); u.pn = (wgid % nig) / gsz; return true;
    }
    __device__ __forceinline__ void a_ready(const Unit&) const {}
    __device__ __forceinline__ void done(const Unit&) const {}
};
struct EpiF32 {
    static constexpr bool PERM = false, AFTER_DRAIN = false;
    float* C; int ldc;
    __device__ __forceinline__ void operator()(const f32x4 (&acc)[2][2][4][2], const Unit& u, int wr, int wc, int fr, int fq) const {
        const int row0 = u.pm * BM + wr * 64 + fr, col0 = u.pn * BM + wc * 32 + 4 * fq;
#pragma unroll
        for (int ai = 0; ai < 2; ++ai)
#pragma unroll
            for (int m = 0; m < 4; ++m) { float* rowp = C + (size_t)(row0 + ai * HALF + m * 16) * ldc + col0;
#pragma unroll
                for (int bj = 0; bj < 2; ++bj)
#pragma unroll
                    for (int n = 0; n < 2; ++n) *(f32x4*)(rowp + bj * HALF + n * 16) = acc[ai][bj][m][n]; }
    }
};
template <int ACT  , bool SIDE  > struct EpiH16 {
    static constexpr bool PERM = true, AFTER_DRAIN = false;
    h16* O; int ldc; float* pf32;
    __device__ __forceinline__ void operator()(const f32x4 (&acc)[2][2][4][2], const Unit& u, int wr, int wc, int fr, int fq) const {
        const int row0 = u.pm * BM + wr * 64 + fr, col0 = u.pn * BM + wc * 32 + 8 * fq;
#pragma unroll
        for (int ai = 0; ai < 2; ++ai)
#pragma unroll
            for (int m = 0; m < 4; ++m) { h16* rowp = O + (size_t)(row0 + ai * HALF + m * 16) * ldc + col0;
#pragma unroll
                for (int bj = 0; bj < 2; ++bj) { f32x4 v0 = acc[ai][bj][m][0], v1 = acc[ai][bj][m][1];
                    if (ACT == 1) {
#pragma unroll
                        for (int j = 0; j < 4; ++j) { const float a = fmaxf(v0[j], 0.f), b = fmaxf(v1[j], 0.f); v0[j] = a * a; v1[j] = b * b; } }
                    u32x4 w; w.x = pk_h2(v0[0], v0[1]); w.y = pk_h2(v0[2], v0[3]); w.z = pk_h2(v1[0], v1[1]); w.w = pk_h2(v1[2], v1[3]);
                    *(u32x4*)(rowp + bj * HALF) = w;
                    if (SIDE) { if (bj == 0 && u.pn * BM + 64 == C_DT && wc == 2 && fq < 2) {
                        float* sp = pf32 + (size_t)(row0 + ai * HALF + m * 16) * 16 + 8 * fq; *(f32x4*)sp = acc[ai][0][m][0]; *(f32x4*)(sp + 4) = acc[ai][0][m][1]; } }
                } }
    }
};
template <class Epi, class Sched, bool ALIGN_EPI = false, bool SP2 = false>
__device__ __forceinline__ void gemm_phase(LAS unsigned char* lds, const Gemm g, const Sched& S, const Epi& E) {
    const int tid = threadIdx.x, wid = __builtin_amdgcn_readfirstlane(tid >> 6), lane = tid & 63, wr = wid >> 2, wc = wid & 3, fr = lane & 15, fq = lane >> 4;
    const int K = g.K, nt = K / BK;
    unsigned voffA[2], voffB[2];
#pragma unroll
    for (int i = 0; i < 2; ++i) { int R, C; stage_rc(tid * 16 + i * 8192, R, C); const int Rb = Epi::PERM ? ((R & ~31) + perm32(R & 31)) : R;
        voffA[i] = (unsigned)(R * K + C) * 2u; voffB[i] = (unsigned)(Rb * K + C) * 2u; }
    const size_t kstep = (size_t)(BK * 2);
    const size_t hstep = (size_t)HALF * K * 2;
    const size_t tstep = 2 * hstep;
    const unsigned ldsw = (unsigned)wid * 1024u;
    const int aoff = lds_byte(wr * 64 + fr, fq * 8), boff = lds_byte(wc * 32 + fr, fq * 8);
#define PG8_SA(b, h) (((b) * 2 + (h)) * HTB)
#define PG8_SB(b, h) ((4 + (b) * 2 + (h)) * HTB)
#define PG8_STAGE(bufoff, gbase, voff) do { _Pragma("unroll") for (int _i = 0; _i < 2; ++_i) \
        __builtin_amdgcn_global_load_lds((const unsigned*)((const char*)(gbase) + (voff)[_i]), (LAS unsigned*)(lds + (bufoff) + ldsw + _i * 8192), 16, 0, 0); } while (0)
#define PG8_LDA(dst, b, h) do { _Pragma("unroll") for (int m = 0; m < 4; ++m) _Pragma("unroll") for (int k = 0; k < 2; ++k) dst[m][k] = *(const LAS h16x8*)(lds + PG8_SA(b, h) + aoff + m * 2048 + k * 1024); } while (0)
#define PG8_LDB(dst, b, h) do { _Pragma("unroll") for (int n = 0; n < 2; ++n) _Pragma("unroll") for (int k = 0; k < 2; ++k) dst[n][k] = *(const LAS h16x8*)(lds + PG8_SB(b, h) + boff + n * 2048 + k * 1024); } while (0)
#define PG8_MMA(ai, bj, At, Bt) do { __builtin_amdgcn_s_setprio(1); _Pragma("unroll") for (int m = 0; m < 4; ++m) _Pragma("unroll") for (int n = 0; n < 2; ++n) _Pragma("unroll") for (int k = 0; k < 2; ++k) \
        acc[ai][bj][m][n] = __builtin_amdgcn_mfma_f32_16x16x32_f16(Bt[n][k], At[m][k], acc[ai][bj][m][n], 0, 0, 0); __builtin_amdgcn_s_setprio(0); } while (0)
#define PG8_WAIT_V(n) asm volatile("s_waitcnt vmcnt(" #n ")" ::: "memory")
#define PG8_WAIT_L(n) asm volatile("s_waitcnt lgkmcnt(" #n ")" ::: "memory")
#define PG8_BAR __builtin_amdgcn_s_barrier()
#define PG8_SCHED __builtin_amdgcn_sched_barrier(0)
    Unit cur, nxt; int ui = 0;
    if (!S.next(0, cur)) return;
    f32x4 acc[2][2][4][2];
#pragma unroll
    for (int a = 0; a < 2; ++a)
#pragma unroll
        for (int b = 0; b < 2; ++b)
#pragma unroll
            for (int m = 0; m < 4; ++m)
#pragma unroll
                for (int n = 0; n < 2; ++n) acc[a][b][m][n] = (f32x4){0.f, 0.f, 0.f, 0.f};
    h16x8 At[4][2], B0[2][2], B1[2][2];
    const char* cA = (const char*)g.A + (size_t)cur.pm * tstep; const char* cB = (const char*)g.Bt + (size_t)cur.pn * tstep;
    S.a_ready(cur);
    if constexpr (SP2) {
        PG8_STAGE(PG8_SB(0, 0), cB, voffB); PG8_STAGE(PG8_SB(0, 1), cB + hstep, voffB); PG8_STAGE(PG8_SA(0, 0), cA, voffA); PG8_STAGE(PG8_SA(0, 1), cA + hstep, voffA);
        if (wr == 1) PG8_BAR;
        PG8_WAIT_V(2); PG8_BAR;
        PG8_STAGE(PG8_SB(1, 0), cB + kstep, voffB); PG8_STAGE(PG8_SA(1, 0), cA + kstep, voffA); PG8_STAGE(PG8_SB(1, 1), cB + hstep + kstep, voffB);
        PG8_WAIT_V(6); PG8_BAR;
    } else {
        PG8_STAGE(PG8_SB(0, 0), cB, voffB); PG8_STAGE(PG8_SA(0, 0), cA, voffA); PG8_STAGE(PG8_SB(0, 1), cB + hstep, voffB); PG8_STAGE(PG8_SA(0, 1), cA + hstep, voffA);
        if (wr == 1) PG8_BAR;
        PG8_WAIT_V(4); PG8_BAR;
        PG8_STAGE(PG8_SB(1, 0), cB + kstep, voffB); PG8_STAGE(PG8_SA(1, 0), cA + kstep, voffA); PG8_STAGE(PG8_SB(1, 1), cB + hstep + kstep, voffB);
        PG8_WAIT_V(6); PG8_BAR;
    }
    for (;;) {
        const bool has_next = S.next(ui + 1, nxt);
        const char* nA = has_next ? (const char*)g.A + (size_t)nxt.pm * tstep : cA; const char* nB = has_next ? (const char*)g.Bt + (size_t)nxt.pn * tstep : cB;
        for (int t = 0; t < nt; t += 2) {
            const bool last = (t == nt - 2);
            const char* a1 = cA + (size_t)(t + 1) * kstep;
            const char* a2 = last ? nA : cA + (size_t)(t + 2) * kstep; const char* b2 = last ? nB : cB + (size_t)(t + 2) * kstep;
            const char* a3 = a2 + kstep; const char* b3 = b2 + kstep;
            if (last && has_next) S.a_ready(nxt);
            if constexpr (SP2) {
            PG8_LDB(B0, 0, 0); PG8_LDB(B1, 0, 1); PG8_SCHED; PG8_LDA(At, 0, 0); PG8_STAGE(PG8_SA(1, 1), a1 + hstep, voffA);
            PG8_WAIT_V(8); PG8_WAIT_L(0); PG8_BAR; PG8_MMA(0, 0, At, B0); PG8_MMA(0, 1, At, B1); PG8_BAR; PG8_SCHED;
            PG8_LDA(At, 0, 1); PG8_STAGE(PG8_SB(0, 0), b2, voffB); PG8_STAGE(PG8_SB(0, 1), b2 + hstep, voffB); PG8_STAGE(PG8_SA(0, 0), a2, voffA);
            PG8_WAIT_V(8); PG8_WAIT_L(0); PG8_BAR; PG8_MMA(1, 0, At, B0); PG8_MMA(1, 1, At, B1); PG8_BAR; PG8_SCHED;
            PG8_LDB(B0, 1, 0); PG8_LDB(B1, 1, 1); PG8_SCHED; PG8_LDA(At, 1, 0); PG8_STAGE(PG8_SA(0, 1), a2 + hstep, voffA);
            PG8_WAIT_V(8); PG8_WAIT_L(0); PG8_BAR; PG8_MMA(0, 0, At, B0); PG8_MMA(0, 1, At, B1); PG8_BAR; PG8_SCHED;
            PG8_LDA(At, 1, 1); PG8_STAGE(PG8_SB(1, 0), b3, voffB); PG8_STAGE(PG8_SB(1, 1), b3 + hstep, voffB); PG8_STAGE(PG8_SA(1, 0), a3, voffA);
            PG8_WAIT_V(8); PG8_WAIT_L(0); PG8_BAR; PG8_MMA(1, 0, At, B0); PG8_MMA(1, 1, At, B1); PG8_BAR; PG8_SCHED;
            } else {
            PG8_LDB(B0, 0, 0); PG8_SCHED; PG8_LDA(At, 0, 0); PG8_STAGE(PG8_SA(1, 1), a1 + hstep, voffA);
            PG8_WAIT_L(8); PG8_BAR; PG8_WAIT_L(0); PG8_MMA(0, 0, At, B0); PG8_BAR; PG8_SCHED;
            PG8_LDB(B1, 0, 1); PG8_STAGE(PG8_SB(0, 0), b2, voffB);
            PG8_BAR; PG8_WAIT_L(0); PG8_MMA(0, 1, At, B1); PG8_BAR;
            PG8_LDA(At, 0, 1); PG8_STAGE(PG8_SA(0, 0), a2, voffA);
            PG8_BAR; PG8_WAIT_L(0); PG8_MMA(1, 0, At, B0); PG8_BAR; PG8_SCHED;
            PG8_STAGE(PG8_SB(0, 1), b2 + hstep, voffB);
            PG8_WAIT_V(6); PG8_BAR; PG8_MMA(1, 1, At, B1); PG8_BAR;
            PG8_LDB(B0, 1, 0); PG8_SCHED; PG8_LDA(At, 1, 0); PG8_STAGE(PG8_SA(0, 1), a2 + hstep, voffA);
            PG8_WAIT_L(8); PG8_BAR; PG8_WAIT_L(0); PG8_MMA(0, 0, At, B0); PG8_BAR; PG8_SCHED;
            PG8_LDB(B1, 1, 1); PG8_STAGE(PG8_SB(1, 0), b3, voffB);
            PG8_BAR; PG8_WAIT_L(0); PG8_MMA(0, 1, At, B1); PG8_BAR;
            PG8_LDA(At, 1, 1); PG8_STAGE(PG8_SA(1, 0), a3, voffA);
            PG8_BAR; PG8_WAIT_L(0); PG8_MMA(1, 0, At, B0); PG8_BAR; PG8_SCHED;
            PG8_STAGE(PG8_SB(1, 1), b3 + hstep, voffB);
            PG8_WAIT_V(6); PG8_BAR; PG8_MMA(1, 1, At, B1); PG8_BAR;
            }
        }
        if constexpr (ALIGN_EPI) { if (wr == 0) PG8_BAR; }
        if constexpr (!Epi::AFTER_DRAIN) { E(acc, cur, wr, wc, fr, fq); S.done(cur); }
        if (!has_next) break;
#pragma unroll
        for (int a = 0; a < 2; ++a)
#pragma unroll
            for (int b = 0; b < 2; ++b)
#pragma unroll
                for (int m = 0; m < 4; ++m)
#pragma unroll
                    for (int n = 0; n < 2; ++n) acc[a][b][m][n] = (f32x4){0.f, 0.f, 0.f, 0.f};
        cur = nxt; cA = nA; cB = nB; ++ui;
        if constexpr (ALIGN_EPI) { if (wr == 1) PG8_BAR; }
    }
    PG8_WAIT_V(0);
    if constexpr (!ALIGN_EPI) { if (wr == 0) PG8_BAR; }
    PG8_BAR;
    if constexpr (Epi::AFTER_DRAIN) { E.fused(acc, cur, wr, wc, fr, fq, lds, wid, lane); S.done(cur); }
#undef PG8_SA
#undef PG8_SB
#undef PG8_STAGE
#undef PG8_LDA
#undef PG8_LDB
#undef PG8_MMA
#undef PG8_WAIT_V
#undef PG8_WAIT_L
#undef PG8_BAR
#undef PG8_SCHED
}
}

#define XB_TMO      128
#define XB_XCNT(j)  (256  + 64 * (j))
#define XB_XSUB(j)  (1280 + 64 * (j))
#define XB_XGEN(j)  (2304 + 64 * (j))
#define XB_TOP      3328
#define XB_TOPGEN   3392
#define XCD_BAR_WORDS 3456
#define XB_SPIN_CAP (1u << 22)
__device__ __forceinline__ unsigned xb_ld(unsigned* p)              { return __hip_atomic_load(p, __ATOMIC_RELAXED, __HIP_MEMORY_SCOPE_AGENT); }
__device__ __forceinline__ unsigned xb_add(unsigned* p, unsigned v) { return __hip_atomic_fetch_add(p, v, __ATOMIC_RELAXED, __HIP_MEMORY_SCOPE_AGENT); }
__device__ __forceinline__ unsigned xb_xcc_id() { return (unsigned)__builtin_amdgcn_s_getreg((3 << 11) | 20) & 0xFu; }
#define XB_SPIN(cond, bar) do { unsigned _sp = 0; while (cond) { __builtin_amdgcn_s_sleep(1); \
    if ((++_sp & 255u) == 0u) { if (xb_ld(&(bar)[XB_TMO])) break; if (_sp > XB_SPIN_CAP) { atomicAdd(&(bar)[XB_TMO], 1u); break; } } } } while (0)
struct XcdBarrier { unsigned* bar; unsigned x; volatile LAS unsigned* st; };
__device__ __forceinline__ XcdBarrier xcd_barrier_post(unsigned* bar, volatile LAS unsigned* st) {
    XcdBarrier b; b.bar = bar; b.x = xb_xcc_id(); b.st = st;
    if (threadIdx.x == 0) (void)xb_add(&bar[XB_XCNT(b.x)], 1u);
    return b;
}
__device__ __forceinline__ void xcd_barrier_complete(unsigned* bar, unsigned x, unsigned& nloc, unsigned& nx) {
    const unsigned G = gridDim.x * gridDim.y * gridDim.z;
    unsigned sum, cnt, mine, sp = 0u;
    for (;;) {
        sum = 0u; cnt = 0u; mine = 0u;
#pragma unroll
        for (unsigned j = 0; j < 16; ++j) { const unsigned c = xb_ld(&bar[XB_XCNT(j)]); sum += c; cnt += (c > 0u) ? 1u : 0u; mine = (j == x) ? c : mine; }
        if (sum == G) break;
        __builtin_amdgcn_s_sleep(1);
        if ((++sp & 255u) == 0u) { if (xb_ld(&bar[XB_TMO])) break; if (sp > XB_SPIN_CAP) { atomicAdd(&bar[XB_TMO], 1u); break; } }
    }
    nloc = mine > 0u ? mine : 1u; nx = cnt > 0u ? cnt : 1u;
}
__device__ __forceinline__ void xcd_barrier(const XcdBarrier& b) {
    asm volatile("s_waitcnt vmcnt(0)" ::: "memory");
    __syncthreads();
    if (threadIdx.x == 0) {
        unsigned* bar = b.bar;
        __builtin_amdgcn_s_waitcnt(0);
        unsigned nloc = b.st[0], nx = b.st[1];
        if (nloc == 0u) { xcd_barrier_complete(bar, b.x, nloc, nx); b.st[0] = nloc; b.st[1] = nx; }
        const unsigned old = xb_add(&bar[XB_XSUB(b.x)], 1u);
        const unsigned gen = old / nloc;
        if (old + 1u == (gen + 1u) * nloc) {
            __builtin_amdgcn_fence(__ATOMIC_RELEASE, "agent");
            asm volatile("s_waitcnt vmcnt(0)" ::: "memory");
            const unsigned og = xb_add(&bar[XB_TOP], 1u);
            const unsigned tg = og / nx;
            if (og + 1u == (tg + 1u) * nx) xb_add(&bar[XB_TOPGEN], 1u);
            else XB_SPIN(xb_ld(&bar[XB_TOPGEN]) == tg, bar);
            __builtin_amdgcn_fence(__ATOMIC_ACQUIRE, "agent");
            xb_add(&bar[XB_XGEN(b.x)], 1u);
            asm volatile("s_waitcnt vmcnt(0)" ::: "memory");
        } else {
            XB_SPIN(xb_ld(&bar[XB_XGEN(b.x)]) == gen, bar);
            __builtin_amdgcn_fence(__ATOMIC_ACQUIRE, "agent");
            asm volatile("s_waitcnt vmcnt(0)" ::: "memory");
        }
    }
    __syncthreads();
}

constexpr int NWAVES = 8, NTHR = NWAVES * 64;
constexpr int RING_BYTES = 131072, MISC_OFF = RING_BYTES, AUX_OFF = MISC_OFF + 256, LDS_BYTES = 147456;
constexpr size_t WS_MODP = WS_MOD + 64 * 1024;
constexpr int CW_BAR = 1024;
constexpr int MAX_LAUNCH = 8;
constexpr size_t CTL_ZERO_BYTES = (size_t)(CW_BAR + MAX_LAUNCH * XCD_BAR_WORDS) * 4;
#define LDS_WAIT() asm volatile("s_waitcnt lgkmcnt(0)" ::: "memory")

struct Args { const float* in[20]; float* out; unsigned char* ws; int ph_lo, ph_hi, li, pad; };
enum { I_X = 0, I_C, I_WADA, I_BADA, I_N1PRE, I_N1POST, I_WIN, I_CONVW, I_CONVB, I_DTB, I_ALOG, I_DSKIP, I_SSMN, I_RELB, I_ATTN, I_WOUT, I_N2PRE, I_N2POST, I_W1, I_W2 };

template <int MODE> __device__ __forceinline__ void p0_transpose_item(const float* W, int K, int N, h16* WT, LAS float* scr, int item, int nblk, int lane) {
    const int kb = item / nblk, nb = item % nblk, k0 = 64 * kb, n0 = 32 * nb;
    const int sc = MODE ? win_src(n0 + (lane & 31)) : n0 + (lane & 31);
#pragma unroll 8
    for (int i = 0; i < 32; ++i) { const int kk = 2 * i + (lane >> 5); scr[kk * 33 + (lane & 31)] = sc >= 0 ? W[(size_t)(k0 + kk) * N + sc] : 0.f; }
    LDS_WAIT(); asm volatile("" ::: "memory");
    const int c = lane & 7;
#pragma unroll
    for (int j = 0; j < 4; ++j) { const int n = (lane >> 3) + 8 * j; const LAS float* s = scr + (8 * c) * 33 + n;
        u32x4 o; o.x = pk_h2(s[0 * 33], s[1 * 33]); o.y = pk_h2(s[2 * 33], s[3 * 33]); o.z = pk_h2(s[4 * 33], s[5 * 33]); o.w = pk_h2(s[6 * 33], s[7 * 33]);
        *(u32x4*)(WT + (size_t)(n0 + n) * K + k0 + 8 * c) = o; }
    LDS_WAIT(); asm volatile("" ::: "memory");
}

__global__ void __launch_bounds__(NTHR, 2) mk_fwd(Args args) {
    extern __shared__ __attribute__((aligned(16))) unsigned char lds_raw[];
    LAS unsigned char* lds = (LAS unsigned char*)lds_raw;
    volatile LAS unsigned* MISC = (volatile LAS unsigned*)(lds + MISC_OFF);
    const int tid = threadIdx.x, lane = tid & 63, wave = __builtin_amdgcn_readfirstlane(tid >> 6);
    const int G = gridDim.x, bx = blockIdx.x, gw = bx * NWAVES + wave, NGW = G * NWAVES;
    unsigned char* ws = args.ws;
    unsigned* ctl = (unsigned*)(ws + WS_CTL);
    const float* x = args.in[I_X]; float* out = args.out;
    float* MOD = (float*)(ws + WS_MOD); float* MODP = (float*)(ws + WS_MODP); float* PF32 = (float*)(ws + WS_PF32);
    h16* WIN = (h16*)(ws + WS_WIN); h16* WOUT = (h16*)(ws + WS_WOUT); h16* W1 = (h16*)(ws + WS_W1); h16* W2 = (h16*)(ws + WS_W2);
    h16* XN = (h16*)(ws + WS_XN); h16* PROJ = (h16*)(ws + WS_PROJ); h16* MIX = (h16*)(ws + WS_MIX);
    float* MIXO = (float*)(ws + WS_MIXO); h16* HB = (h16*)(ws + WS_H); float* FB = (float*)(ws + WS_F);
    if (tid < 64) MISC[tid] = 0u;
    __syncthreads();
    XcdBarrier bar = xcd_barrier_post(ctl + CW_BAR + args.li * XCD_BAR_WORDS, MISC + 8);
    const int lo = args.ph_lo, hi = args.ph_hi;
#define IN(k) (lo <= (k) && (k) < hi)
#define SEAM(k) do { if (IN(k) && IN((k) + 1)) xcd_barrier(bar); } while (0)

    if (IN(0)) {
        LAS float* scr = (LAS float*)(lds + wave * 16384);
        constexpr int I_IN = 16 * 96, I_O = 16 * 32, I_1 = 16 * 128, I_2 = 64 * 32, I_M = 96 * 16, NITEMS = I_IN + I_O + I_1 + I_2 + I_M;
        for (int it = gw; it < NITEMS; it += NGW) {
            int r = it;
            if (r < I_IN) { p0_transpose_item<1>(args.in[I_WIN], D, 2896, WIN, scr, r, 96, lane); continue; } r -= I_IN;
            if (r < I_O) { p0_transpose_item<0>(args.in[I_WOUT], D, D, WOUT, scr, r, 32, lane); continue; } r -= I_O;
            if (r < I_1) { p0_transpose_item<0>(args.in[I_W1], D, FF, W1, scr, r, 128, lane); continue; } r -= I_1;
            if (r < I_2) { p0_transpose_item<0>(args.in[I_W2], FF, D, W2, scr, r, 32, lane); continue; } r -= I_2;
            const int cg = r % 96, ks = r / 96, jj = cg * 64 + lane, k0 = ks * 64;
            const float s0 = silu_f(args.in[I_C][k0 + lane]), s1 = silu_f(args.in[I_C][D + k0 + lane]);
            const float* wp = args.in[I_WADA] + (size_t)k0 * (6 * D) + jj; float a0 = 0.f, a1 = 0.f;
#pragma unroll 16
            for (int kk = 0; kk < 64; ++kk) { const float w = wp[(size_t)kk * (6 * D)]; a0 += __shfl(s0, kk) * w; a1 += __shfl(s1, kk) * w; }
            MODP[(size_t)(ks * 2 + 0) * (6 * D) + jj] = a0; MODP[(size_t)(ks * 2 + 1) * (6 * D) + jj] = a1;
        }
    }
    SEAM(0);
    if (IN(1)) {
        for (int i = bx * NTHR + tid; i < NB * 6 * D; i += G * NTHR) { const int b = i / (6 * D), jj = i % (6 * D); float a = args.in[I_BADA][jj];
#pragma unroll
            for (int ks = 0; ks < 16; ++ks) a += MODP[(size_t)(ks * 2 + b) * (6 * D) + jj];
            MOD[i] = a; }
        LAS float* mv = (LAS float*)lds;
        for (int i = tid; i < NB * 2 * D; i += NTHR) { const int b = i / (2 * D), jj = i % (2 * D); float a = args.in[I_BADA][jj];
#pragma unroll
            for (int ks = 0; ks < 16; ++ks) a += MODP[(size_t)(ks * 2 + b) * (6 * D) + jj];
            mv[i] = a; }
        __syncthreads();
        const float* g1 = args.in[I_N1PRE];
        for (int m = gw; m < M; m += NGW) {
            const int b = m / T; const f32x4* xr = (const f32x4*)(x + (size_t)m * D) + lane; f32x4 v[4]; float ss = 0.f;
#pragma unroll
            for (int j = 0; j < 4; ++j) { v[j] = xr[64 * j]; ss += (v[j].x * v[j].x + v[j].y * v[j].y) + (v[j].z * v[j].z + v[j].w * v[j].w); }
            const float rstd = rsqrtf(wave_sum(ss) * (1.f / D) + EPS);
            u32x2* o8 = (u32x2*)(XN + (size_t)m * D) + lane;
#pragma unroll
            for (int j = 0; j < 4; ++j) { const int k = 4 * lane + 256 * j; const f32x4 gg = *(const f32x4*)(g1 + k);
                const f32x4 sh = *(const LAS f32x4*)(mv + b * 2 * D + k), sc = *(const LAS f32x4*)(mv + b * 2 * D + D + k);
                const f32x4 r = v[j] * rstd * gg * (sc + 1.f) + sh; u32x2 w; w.x = pk_h2(r.x, r.y); w.y = pk_h2(r.z, r.w); o8[64 * j] = w; }
        }
        __syncthreads();
    }
    SEAM(1);
    if (IN(2)) {
        pg8::Gemm g{XN, WIN, M, NPROJ, D}; pg8::StaticOrder S; S.init(M, NPROJ, G, bx);
        pg8::EpiH16<0, true> E{PROJ, NPROJ, PF32};
        pg8::gemm_phase<pg8::EpiH16<0, true>, pg8::StaticOrder, true, true>(lds, g, S, E);
    }
    SEAM(2);
    if (IN(9)) {
        pg8::Gemm g{MIX, WOUT, M, D, D}; pg8::StaticOrder S; S.init(M, D, G, bx);
        pg8::EpiF32 E{MIXO, D};
        pg8::gemm_phase<pg8::EpiF32, pg8::StaticOrder, true, true>(lds, g, S, E);
    }
    SEAM(9);
    if (IN(10)) {
        const float* w1p = args.in[I_N1POST]; const float* w2p = args.in[I_N2PRE];
        for (int m = gw; m < M; m += NGW) {
            const int b = m / T; const float* md = MOD + (size_t)b * 6 * D; const f32x4* mr = (const f32x4*)(MIXO + (size_t)m * D) + lane; const f32x4* xr = (const f32x4*)(x + (size_t)m * D) + lane;
            f32x4 v[4]; float ss = 0.f;
#pragma unroll
            for (int j = 0; j < 4; ++j) { v[j] = mr[64 * j]; ss += (v[j].x * v[j].x + v[j].y * v[j].y) + (v[j].z * v[j].z + v[j].w * v[j].w); }
            float rstd = rsqrtf(wave_sum(ss) * (1.f / D) + EPS); ss = 0.f;
            f32x4* orow = (f32x4*)(out + (size_t)m * D) + lane;
#pragma unroll
            for (int j = 0; j < 4; ++j) { const int k = 4 * lane + 256 * j; const f32x4 gt = *(const f32x4*)(md + 2 * D + k), wp = *(const f32x4*)(w1p + k);
                v[j] = xr[64 * j] + gt * (v[j] * rstd * wp); orow[64 * j] = v[j]; ss += (v[j].x * v[j].x + v[j].y * v[j].y) + (v[j].z * v[j].z + v[j].w * v[j].w); }
            rstd = rsqrtf(wave_sum(ss) * (1.f / D) + EPS);
            u32x2* o8 = (u32x2*)(XN + (size_t)m * D) + lane;
#pragma unroll
            for (int j = 0; j < 4; ++j) { const int k = 4 * lane + 256 * j; const f32x4 gg = *(const f32x4*)(w2p + k), sh = *(const f32x4*)(md + 3 * D + k), sc = *(const f32x4*)(md + 4 * D + k);
                const f32x4 r = v[j] * rstd * gg * (sc + 1.f) + sh; u32x2 w; w.x = pk_h2(r.x, r.y); w.y = pk_h2(r.z, r.w); o8[64 * j] = w; }
        }
    }
    SEAM(10);
    if (IN(11)) {
        pg8::Gemm g{XN, W1, M, FF, D}; pg8::StaticOrder S; S.init(M, FF, G, bx);
        pg8::EpiH16<1, false> E{HB, FF, nullptr};
        pg8::gemm_phase<pg8::EpiH16<1, false>, pg8::StaticOrder, true, true>(lds, g, S, E);
    }
    SEAM(11);
    if (IN(12)) {
        pg8::Gemm g{HB, W2, M, D, FF}; pg8::StaticOrder S; S.init(M, D, G, bx);
        pg8::EpiF32 E{FB, D};
        pg8::gemm_phase<pg8::EpiF32, pg8::StaticOrder, true, true>(lds, g, S, E);
    }
    SEAM(12);
    if (IN(13)) {
        const float* w2post = args.in[I_N2POST];
        for (int m = gw; m < M; m += NGW) {
            const int b = m / T; const float* md = MOD + (size_t)b * 6 * D; const f32x4* fr = (const f32x4*)(FB + (size_t)m * D) + lane;
            f32x4 v[4]; float ss = 0.f;
#pragma unroll
            for (int j = 0; j < 4; ++j) { v[j] = fr[64 * j]; ss += (v[j].x * v[j].x + v[j].y * v[j].y) + (v[j].z * v[j].z + v[j].w * v[j].w); }
            const float rstd = rsqrtf(wave_sum(ss) * (1.f / D) + EPS);
            f32x4* orow = (f32x4*)(out + (size_t)m * D) + lane;
#pragma unroll
            for (int j = 0; j < 4; ++j) { const int k = 4 * lane + 256 * j; const f32x4 gt = *(const f32x4*)(md + 5 * D + k), wp = *(const f32x4*)(w2post + k);
                orow[64 * j] = orow[64 * j] + gt * (v[j] * rstd * wp); }
        }
    }
#undef IN
#undef SEAM
}

static int g_grid = 0;
static void mk_launch(Args& a, int lo, int hi, int li, hipStream_t stream) {
    a.ph_lo = lo; a.ph_hi = hi; a.li = li;
    hipLaunchKernelGGL(mk_fwd, dim3(g_grid), dim3(NTHR), LDS_BYTES, stream, a);
}

extern "C" void kernel_launch(void* const* d_in, const int* in_sizes, int n_in, void* d_out, int out_size, void* d_ws, size_t ws_size, hipStream_t stream) {
    const float* x = (const float*)d_in[0]; const float* c = (const float*)d_in[1]; const float* w_ada = (const float*)d_in[2]; const float* b_ada = (const float*)d_in[3];
    const float* norm1_pre = (const float*)d_in[4]; const float* norm1_post = (const float*)d_in[5]; const float* w_in = (const float*)d_in[6];
    const float* conv_w = (const float*)d_in[7]; const float* conv_b = (const float*)d_in[8]; const float* dt_bias = (const float*)d_in[9];
    const float* a_log = (const float*)d_in[10]; const float* d_skip = (const float*)d_in[11]; const float* ssm_norm = (const float*)d_in[12];
    const float* rel_bias = (const float*)d_in[13]; const float* attn_norm = (const float*)d_in[14]; const float* w_out = (const float*)d_in[15];
    const float* norm2_pre = (const float*)d_in[16]; const float* norm2_post = (const float*)d_in[17]; const float* w_mlp_in = (const float*)d_in[18]; const float* w_mlp_out = (const float*)d_in[19];
    unsigned char* ws = (unsigned char*)d_ws; unsigned char* dob = (unsigned char*)d_out; float* out = (float*)d_out;
    float* MOD = (float*)(ws + WS_MOD); float* PF32 = (float*)(ws + WS_PF32);
    h16* WIN = (h16*)(ws + WS_WIN); h16* WOUT = (h16*)(ws + WS_WOUT); h16* W1 = (h16*)(ws + WS_W1); h16* W2 = (h16*)(ws + WS_W2);
    h16* XN = (h16*)(ws + WS_XN); h16* PROJ = (h16*)(ws + WS_PROJ); h16* MIX = (h16*)(ws + WS_MIX); unsigned short* IDX = (unsigned short*)(ws + WS_IDX);
    float* YTMP = (float*)(ws + WS_YTMP); float* DTV = (float*)(ws + WS_DT); float* MIXO = (float*)(ws + WS_MIXO); h16* HB = (h16*)(ws + WS_H); float* FB = (float*)(ws + WS_F);
    h16* XC = (h16*)(dob + DO_XC); float* SLAB = (float*)dob;

    if (g_grid == 0) {
        int dev = 0, cus = 0;
        if (hipGetDevice(&dev) != hipSuccess || hipDeviceGetAttribute(&cus, hipDeviceAttributeMultiprocessorCount, dev) != hipSuccess) { fprintf(stderr, "kernel_launch: device query failed\n"); g_grid = -1; return; }
        if (hipFuncSetAttribute((const void*)mk_fwd, hipFuncAttributeMaxDynamicSharedMemorySize, LDS_BYTES) != hipSuccess) { fprintf(stderr, "kernel_launch: hipFuncSetAttribute failed\n"); g_grid = -1; return; }
        g_grid = cus;
        if (ws_size < 256 * MiB) fprintf(stderr, "kernel_launch: workspace too small: %zu\n", ws_size);
    }
    if (g_grid < 0) return;
    (void)hipMemsetAsync(ws + WS_CTL, 0, CTL_ZERO_BYTES, stream);
    Args a{};
    for (int i = 0; i < 20; ++i) a.in[i] = (const float*)d_in[i];
    a.out = out; a.ws = ws;
    int li = 0;
    mk_launch(a, 0, 3, li++, stream);
    nv::conv<<<(M * 1024) / 256, 256, 0, stream>>>(PROJ, PF32, conv_w, conv_b, dt_bias, XC, DTV);
    nv::ssd_rec<<<NB * 8, 64, 0, stream>>>(XC, DTV, a_log, d_skip, YTMP);
    nv::norm512<<<M / 4, 256, 0, stream>>>(YTMP, PROJ, 1, ssm_norm, MIX, 0);
    for (int q0 = 0; q0 < M; q0 += 1024) {
        nv::scores<<<dim3(T / 256, 1024), 256, 0, stream>>>(PROJ, PF32, q0, SLAB);
        nv::select<<<1024, 256, 0, stream>>>(SLAB, q0, IDX);
    }
    nv::attn<<<M * 8 / 256, 256, 0, stream>>>(PROJ, IDX, rel_bias, YTMP);
    nv::norm512<<<M / 4, 256, 0, stream>>>(YTMP, PROJ, 0, attn_norm, MIX, 512);
    mk_launch(a, 9, 14, li++, stream);
}
```

```cpp
#include <hip/hip_runtime.h>
#include <cstdio>
#include <cstdint>

typedef _Float16 h16;
typedef _Float16 h16x4 __attribute__((ext_vector_type(4)));
typedef _Float16 h16x8 __attribute__((ext_vector_type(8)));
typedef float f32x4 __attribute__((ext_vector_type(4)));

constexpr int NB = 2, T = 8192, D = 1024, M = NB * T, FF = 4096;
constexpr int NPROJ = 3072;
constexpr int C_Z = 0, C_XBC = 512, C_Q = 1536, C_K = 2048, C_V = 2176, C_QI = 2304, C_KI = 2816, C_DT = 2880, C_WI = 2888, C_END = 2896;
constexpr float EPS = 1e-6f;
constexpr int TOPK = 256;

constexpr size_t MiB = 1u << 20;
constexpr size_t WS_CTL = 0, WS_MOD = 1 * MiB, WS_PF32 = 2 * MiB;
constexpr size_t WS_WIN = 4 * MiB, WS_WOUT = 10 * MiB, WS_W1 = 12 * MiB, WS_W2 = 20 * MiB;
constexpr size_t WS_XN = 28 * MiB, WS_PROJ = 60 * MiB;
constexpr size_t WS_STATES = 156 * MiB, WS_PREV = 172 * MiB, WS_DT = 180 * MiB, WS_ACS = WS_DT + 512 * 1024;
constexpr size_t WS_MIX = 181 * MiB, WS_IDX = 213 * MiB, WS_YTMP = 221 * MiB;
constexpr size_t WS_MIXO = 60 * MiB, WS_H = 60 * MiB, WS_F = 188 * MiB;
constexpr size_t DO_XC = 0, DO_XST = 32 * MiB, DO_BT = 48 * MiB;

__device__ __forceinline__ float silu_f(float x) { return x / (1.f + __expf(-x)); }
__device__ __forceinline__ float softplus_f(float x) { return fmaxf(x, 0.f) + log1pf(__expf(-fabsf(x))); }
__device__ __forceinline__ float wave_sum(float v) {
#pragma unroll
    for (int o = 1; o < 64; o <<= 1) v += __shfl_xor(v, o);
    return v;
}
__device__ __forceinline__ int win_src(int n) {
    if (n < C_Q) return n;
    if (n < C_DT) return n + 8;
    if (n < C_WI) return n - C_DT + 1536;
    if (n < C_END) return n;
    return -1;
}
__device__ __forceinline__ int t5_bucket(int n) {
    if (n < 16) return n;
    int b = 16;
    b += (n >= 19); b += (n >= 21); b += (n >= 24); b += (n >= 27); b += (n >= 31); b += (n >= 35); b += (n >= 40); b += (n >= 46);
    b += (n >= 52); b += (n >= 59); b += (n >= 67); b += (n >= 77); b += (n >= 87); b += (n >= 99); b += (n >= 113);
    return b;
}
__device__ __forceinline__ unsigned fkey(float f) { unsigned u = __float_as_uint(f); return (u & 0x80000000u) ? ~u : (u | 0x80000000u); }

namespace nv {
__global__ void prep_w(const float* W, int K, int N, h16* WT, int NT, int mode) {
    const size_t i = (size_t)blockIdx.x * blockDim.x + threadIdx.x; if (i >= (size_t)NT * K) return;
    const int n = (int)(i / K), k = (int)(i % K); const int s = mode ? win_src(n) : n;
    WT[i] = (h16)(s < 0 ? 0.f : W[(size_t)k * N + s]);
}
__global__ void modk(const float* c, const float* w_ada, const float* b_ada, float* mod) {
    const int j = blockIdx.x * blockDim.x + threadIdx.x; if (j >= NB * 6 * D) return;
    const int b = j / (6 * D), jj = j % (6 * D); float acc = b_ada[jj];
    for (int k = 0; k < D; ++k) acc += silu_f(c[b * D + k]) * w_ada[(size_t)k * 6 * D + jj];
    mod[j] = acc;
}
__global__ void norm_mod(const float* x, const float* g, const float* mod, int ci, h16* xn) {
    const int m = blockIdx.x * (blockDim.x / 64) + (threadIdx.x >> 6), lane = threadIdx.x & 63; if (m >= M) return;
    const int b = m / T; const float* xr = x + (size_t)m * D; float v[16]; float ss = 0.f;
#pragma unroll
    for (int j = 0; j < 16; ++j) { v[j] = xr[lane + 64 * j]; ss += v[j] * v[j]; }
    const float rstd = rsqrtf(wave_sum(ss) * (1.f / D) + EPS);
    const float* sh = mod + (size_t)b * 6 * D + ci * D; const float* sc = sh + D;
#pragma unroll
    for (int j = 0; j < 16; ++j) { const int k = lane + 64 * j; xn[(size_t)m * D + k] = (h16)(v[j] * rstd * g[k] * (1.f + sc[k]) + sh[k]); }
}
struct EpiProj { h16* proj; float* pf32;
    __device__ void operator()(int m, int n, float v) const { proj[(size_t)m * NPROJ + n] = (h16)v; if (n >= C_DT && n < C_END) pf32[(size_t)m * 16 + (n - C_DT)] = v; } };
struct EpiF32 { float* C; int ldc; __device__ void operator()(int m, int n, float v) const { C[(size_t)m * ldc + n] = v; } };
struct EpiRelu2 { h16* C; int ldc; __device__ void operator()(int m, int n, float v) const { const float r = fmaxf(v, 0.f); C[(size_t)m * ldc + n] = (h16)(r * r); } };
template <class Epi> __global__ void __launch_bounds__(256) gemm(const h16* A, const h16* Bt, int Mm, int N, int K, Epi epi) {
    __shared__ float As[16][65], Bs[16][65];
    const int tid = threadIdx.x, tx = tid & 15, ty = tid >> 4, m0 = blockIdx.y * 64, n0 = blockIdx.x * 64;
    float acc[4][4] = {};
    const int lr = tid >> 2, lk = (tid & 3) * 4;
    for (int k0 = 0; k0 < K; k0 += 16) {
        const h16x4 a = *(const h16x4*)(A + (size_t)(m0 + lr) * K + k0 + lk), b = *(const h16x4*)(Bt + (size_t)(n0 + lr) * K + k0 + lk);
#pragma unroll
        for (int j = 0; j < 4; ++j) { As[lk + j][lr] = (float)a[j]; Bs[lk + j][lr] = (float)b[j]; }
        __syncthreads();
#pragma unroll
        for (int k = 0; k < 16; ++k) { float av[4], bv[4];
#pragma unroll
            for (int i = 0; i < 4; ++i) { av[i] = As[k][ty * 4 + i]; bv[i] = Bs[k][tx * 4 + i]; }
#pragma unroll
            for (int i = 0; i < 4; ++i)
#pragma unroll
                for (int j = 0; j < 4; ++j) acc[i][j] += av[i] * bv[j]; }
        __syncthreads();
    }
#pragma unroll
    for (int i = 0; i < 4; ++i)
#pragma unroll
        for (int j = 0; j < 4; ++j) epi(m0 + ty * 4 + i, n0 + tx * 4 + j, acc[i][j]);
}
__global__ void conv(const h16* proj, const float* pf32, const float* cw, const float* cb, const float* dt_bias, h16* xc, float* dtv) {
    const size_t i = (size_t)blockIdx.x * blockDim.x + threadIdx.x; if (i >= (size_t)M * 1024) return;
    const int m = (int)(i >> 10), ch = (int)(i & 1023), t = m % T; float acc = cb[ch];
#pragma unroll
    for (int w = 0; w < 4; ++w) { const int tt = t - 3 + w; if (tt >= 0) acc += cw[w * 1024 + ch] * (float)proj[(size_t)(m - 3 + w) * NPROJ + C_XBC + ch]; }
    xc[i] = (h16)silu_f(acc);
    if (ch < 8) dtv[(size_t)m * 8 + ch] = softplus_f(pf32[(size_t)m * 16 + ch] + dt_bias[ch]);
}
__global__ void __launch_bounds__(64) ssd_rec(const h16* xc, const float* dtv, const float* a_log, const float* d_skip, float* y) {
    const int b = blockIdx.x / 8, h = blockIdx.x % 8, g = h / 4, p = threadIdx.x;
    const float a = -__expf(a_log[h]), dsk = d_skip[h]; float st[128];
#pragma unroll
    for (int n = 0; n < 128; ++n) st[n] = 0.f;
    for (int t = 0; t < T; ++t) {
        const size_t m = (size_t)b * T + t; const float dt = dtv[m * 8 + h], dA = __expf(a * dt), xs = (float)xc[m * 1024 + h * 64 + p], xdt = xs * dt;
        const h16* Bp = xc + m * 1024 + 512 + g * 128; const h16* Cp = xc + m * 1024 + 768 + g * 128; float acc = 0.f;
#pragma unroll
        for (int n = 0; n < 128; ++n) { st[n] = st[n] * dA + (float)Bp[n] * xdt; acc += (float)Cp[n] * st[n]; }
        y[m * 512 + h * 64 + p] = acc + dsk * xs;
    }
}
__global__ void norm512(const float* y, const h16* proj, int gate, const float* w, h16* mix, int coff) {
    const int m = blockIdx.x * (blockDim.x / 64) + (threadIdx.x >> 6), lane = threadIdx.x & 63; if (m >= M) return;
    float v[8]; float ss = 0.f;
#pragma unroll
    for (int j = 0; j < 8; ++j) { const int k = lane + 64 * j; float u = y[(size_t)m * 512 + k]; if (gate) u *= silu_f((float)proj[(size_t)m * NPROJ + C_Z + k]); v[j] = u; ss += u * u; }
    const float rstd = rsqrtf(wave_sum(ss) * (1.f / 512.f) + EPS);
#pragma unroll
    for (int j = 0; j < 8; ++j) { const int k = lane + 64 * j; mix[(size_t)m * D + coff + k] = (h16)(v[j] * rstd * w[k]); }
}
__global__ void __launch_bounds__(256) scores(const h16* proj, const float* pf32, int q0, float* slab) {
    __shared__ float qs[512]; __shared__ float ws[8];
    const int ql = blockIdx.y, m = q0 + ql, t = m % T, b = m / T, s = blockIdx.x * 256 + threadIdx.x;
    if (blockIdx.x * 256 > t) return;
    for (int i = threadIdx.x; i < 512; i += 256) qs[i] = (float)proj[(size_t)m * NPROJ + C_QI + i];
    if (threadIdx.x < 8) ws[threadIdx.x] = pf32[(size_t)m * 16 + 8 + threadIdx.x] * 0.35355339059327373f * 0.125f;
    __syncthreads();
    float kv[64]; const h16* kp = proj + (size_t)(b * T + s) * NPROJ + C_KI;
#pragma unroll
    for (int d = 0; d < 64; ++d) kv[d] = (float)kp[d];
    float sc = 0.f;
    for (int h = 0; h < 8; ++h) { float dot = 0.f;
#pragma unroll
        for (int d = 0; d < 64; ++d) dot += qs[h * 64 + d] * kv[d];
        sc += ws[h] * fmaxf(dot, 0.f); }
    slab[(size_t)ql * T + s] = sc;
}
__global__ void __launch_bounds__(256) select(const float* slab, int q0, unsigned short* idx) {
    __shared__ unsigned red[256]; __shared__ unsigned sh_cnt;
    const int ql = blockIdx.x, m = q0 + ql, t = m % T, n = t + 1, tid = threadIdx.x;
    unsigned short* out = idx + (size_t)m * TOPK;
    if (n <= TOPK) { out[tid] = (unsigned short)(tid < n ? tid : 0); return; }
    unsigned key[32];
#pragma unroll
    for (int j = 0; j < 32; ++j) { const int i = tid * 32 + j; key[j] = i < n ? fkey(slab[(size_t)ql * T + i]) : 0u; }
    unsigned Kt = 0u;
    for (int bit = 31; bit >= 0; --bit) {
        const unsigned cand = Kt | (1u << bit); unsigned c = 0;
#pragma unroll
        for (int j = 0; j < 32; ++j) c += (key[j] >= cand);
        if (tid == 0) sh_cnt = 0u; __syncthreads();
        atomicAdd(&sh_cnt, c); __syncthreads();
        if (sh_cnt >= (unsigned)TOPK) Kt = cand;
        __syncthreads();
    }
    unsigned cg = 0, ce = 0;
#pragma unroll
    for (int j = 0; j < 32; ++j) { cg += (key[j] > Kt); ce += (key[j] == Kt); }
    red[tid] = (cg << 16) | ce; __syncthreads();
    unsigned pg = 0, pe = 0, tg = 0;
    for (int i = 0; i < 256; ++i) { const unsigned r = red[i]; if (i < tid) { pg += r >> 16; pe += r & 0xffffu; } tg += r >> 16; }
    const unsigned need = (unsigned)TOPK - tg;
    unsigned sel_before = pg + (pe < need ? pe : need);
#pragma unroll
    for (int j = 0; j < 32; ++j) {
        bool s = false;
        if (key[j] > Kt) s = true; else if (key[j] == Kt) { s = pe < need; ++pe; }
        if (s) { out[sel_before] = (unsigned short)(tid * 32 + j); ++sel_before; }
    }
}
__global__ void __launch_bounds__(256) attn(const h16* proj, const unsigned short* idx, const float* rel_bias, float* y) {
    const int gid = blockIdx.x * 256 + threadIdx.x, m = gid >> 3, h = gid & 7, g = h >> 2, t = m % T, b = m / T;
    const int cnt = (t + 1 < TOPK) ? t + 1 : TOPK;
    float q[64], acc[64];
#pragma unroll
    for (int d = 0; d < 64; ++d) { q[d] = (float)proj[(size_t)m * NPROJ + C_Q + h * 64 + d] * 0.125f; acc[d] = 0.f; }
    float mx = -INFINITY, l = 0.f;
    for (int j = 0; j < cnt; ++j) {
        const int s = idx[(size_t)m * TOPK + j]; const h16* kp = proj + (size_t)(b * T + s) * NPROJ + C_K + g * 64; const h16* vp = kp + (C_V - C_K);
        float lg = rel_bias[t5_bucket(t - s) * 8 + h];
#pragma unroll
        for (int d = 0; d < 64; ++d) lg += q[d] * (float)kp[d];
        const float mn = fmaxf(mx, lg), sc = __expf(mx - mn), pe = __expf(lg - mn);
        l = l * sc + pe; mx = mn;
#pragma unroll
        for (int d = 0; d < 64; ++d) acc[d] = acc[d] * sc + pe * (float)vp[d];
    }
    const float inv = 1.f / l;
#pragma unroll
    for (int d = 0; d < 64; ++d) y[(size_t)m * 512 + h * 64 + d] = acc[d] * inv;
}
__global__ void post1(const float* x, const float* mixo, const float* mod, const float* w1post, const float* w2pre, float* out, h16* xn) {
    const int m = blockIdx.x * (blockDim.x / 64) + (threadIdx.x >> 6), lane = threadIdx.x & 63; if (m >= M) return;
    const int b = m / T; const float* md = mod + (size_t)b * 6 * D; float v[16]; float ss = 0.f;
#pragma unroll
    for (int j = 0; j < 16; ++j) { v[j] = mixo[(size_t)m * D + lane + 64 * j]; ss += v[j] * v[j]; }
    float rstd = rsqrtf(wave_sum(ss) * (1.f / D) + EPS); ss = 0.f;
#pragma unroll
    for (int j = 0; j < 16; ++j) { const int k = lane + 64 * j; v[j] = x[(size_t)m * D + k] + md[2 * D + k] * (v[j] * rstd * w1post[k]); out[(size_t)m * D + k] = v[j]; ss += v[j] * v[j]; }
    rstd = rsqrtf(wave_sum(ss) * (1.f / D) + EPS);
#pragma unroll
    for (int j = 0; j < 16; ++j) { const int k = lane + 64 * j; xn[(size_t)m * D + k] = (h16)(v[j] * rstd * w2pre[k] * (1.f + md[4 * D + k]) + md[3 * D + k]); }
}
__global__ void post2(const float* f, const float* mod, const float* w2post, float* out) {
    const int m = blockIdx.x * (blockDim.x / 64) + (threadIdx.x >> 6), lane = threadIdx.x & 63; if (m >= M) return;
    const int b = m / T; const float* md = mod + (size_t)b * 6 * D; float v[16]; float ss = 0.f;
#pragma unroll
    for (int j = 0; j < 16; ++j) { v[j] = f[(size_t)m * D + lane + 64 * j]; ss += v[j] * v[j]; }
    const float rstd = rsqrtf(wave_sum(ss) * (1.f / D) + EPS);
#pragma unroll
    for (int j = 0; j < 16; ++j) { const int k = lane + 64 * j; out[(size_t)m * D + k] += md[5 * D + k] * (v[j] * rstd * w2post[k]); }
}
}


#define LAS __attribute__((address_space(3)))
#define GAS __attribute__((address_space(1)))
typedef unsigned u32x4 __attribute__((ext_vector_type(4)));
typedef unsigned u32x2 __attribute__((ext_vector_type(2)));
typedef float f32x2 __attribute__((ext_vector_type(2)));
typedef _Float16 h16x2 __attribute__((ext_vector_type(2)));
typedef float f32x16 __attribute__((ext_vector_type(16)));
__device__ __forceinline__ unsigned pk_h2(float lo, float hi) { const f32x2 v = {lo, hi}; const h16x2 h = __builtin_convertvector(v, h16x2); return __builtin_bit_cast(unsigned, h); }

namespace pg8 {
constexpr int BM = 256, BK = 64, HALF = 128, HTB = HALF * BK * 2, STAGE_BYTES = 8 * HTB, NXCD = 8, WGM = 8;
__host__ __device__ __forceinline__ int lds_byte(int r, int c) { const int st = (r >> 4) * 2 + (c >> 5), rr = r & 15, cc = c & 31, ob = rr * 64 + cc * 2; return st * 1024 + (ob ^ (((ob >> 9) & 1) << 5)); }
__host__ __device__ __forceinline__ void stage_rc(int b, int& R, int& C) { const int st = b / 1024, sb = b % 1024, swz = sb ^ (((sb >> 9) & 1) << 5); R = (st >> 1) * 16 + swz / 64; C = (st & 1) * 32 + (swz % 64) / 2; }
__host__ __device__ __forceinline__ int perm32(int rho) { const int n = rho >> 4, i = rho & 15; return 8 * (i >> 2) + 4 * n + (i & 3); }
struct Unit { int pm, pn; };
struct Gemm { const h16* A; const h16* Bt; int M, N, K; };
struct StaticOrder {
    int nM, nN, nwg, G, c;
    __host__ __device__ void init(int M_, int N_, int G_, int c_) { nM = M_ / BM; nN = N_ / BM; nwg = nM * nN; G = G_; c = c_; }
    __host__ __device__ bool next(int i, Unit& u) const {
        const long L = (long)i * G + c; if (L >= nwg) return false;
        int wgid = (int)L; { const int q = nwg / NXCD, r = nwg % NXCD, xcd = wgid % NXCD, off = wgid / NXCD; wgid = (xcd < r ? xcd * (q + 1) : r * (q + 1) + (xcd - r) * q) + off; }
        const int nig = WGM * nN, gid = wgid / nig, fm = gid * WGM, gsz = (nM - fm) < WGM ? (nM - fm) : WGM;
        u.pm = fm + ((wgid % nig) % gsz); u.pn = (wgid % nig) / gsz; return true;
    }
    __device__ __forceinline__ void a_ready(const Unit&) const {}
    __device__ __forceinline__ void done(const Unit&) const {}
};
struct EpiF32 {
    static constexpr bool PERM = false, AFTER_DRAIN = false;
    float* C; int ldc;
    __device__ __forceinline__ void operator()(const f32x4 (&acc)[2][2][4][2], const Unit& u, int wr, int wc, int fr, int fq) const {
        const int row0 = u.pm * BM + wr * 64 + fr, col0 = u.pn * BM + wc * 32 + 4 * fq;
#pragma unroll
        for (int ai = 0; ai < 2; ++ai)
#pragma unroll
            for (int m = 0; m < 4; ++m) { float* rowp = C + (size_t)(row0 + ai * HALF + m * 16) * ldc + col0;
#pragma unroll
                for (int bj = 0; bj < 2; ++bj)
#pragma unroll
                    for (int n = 0; n < 2; ++n) *(f32x4*)(rowp + bj * HALF + n * 16) = acc[ai][bj][m][n]; }
    }
};
template <int ACT  , bool SIDE  > struct EpiH16 {
    static constexpr bool PERM = true, AFTER_DRAIN = false;
    h16* O; int ldc; float* pf32;
    __device__ __forceinline__ void operator()(const f32x4 (&acc)[2][2][4][2], const Unit& u, int wr, int wc, int fr, int fq) const {
        const int row0 = u.pm * BM + wr * 64 + fr, col0 = u.pn * BM + wc * 32 + 8 * fq;
#pragma unroll
        for (int ai = 0; ai < 2; ++ai)
#pragma unroll
            for (int m = 0; m < 4; ++m) { h16* rowp = O + (size_t)(row0 + ai * HALF + m * 16) * ldc + col0;
#pragma unroll
                for (int bj = 0; bj < 2; ++bj) { f32x4 v0 = acc[ai][bj][m][0], v1 = acc[ai][bj][m][1];
                    if (ACT == 1) {
#pragma unroll
                        for (int j = 0; j < 4; ++j) { const float a = fmaxf(v0[j], 0.f), b = fmaxf(v1[j], 0.f); v0[j] = a * a; v1[j] = b * b; } }
                    u32x4 w; w.x = pk_h2(v0[0], v0[1]); w.y = pk_h2(v0[2], v0[3]); w.z = pk_h2(v1[0], v1[1]); w.w = pk_h2(v1[2], v1[3]);
                    *(u32x4*)(rowp + bj * HALF) = w;
                    if (SIDE) { if (bj == 0 && u.pn * BM + 64 == C_DT && wc == 2 && fq < 2) {
                        float* sp = pf32 + (size_t)(row0 + ai * HALF + m * 16) * 16 + 8 * fq; *(f32x4*)sp = acc[ai][0][m][0]; *(f32x4*)(sp + 4) = acc[ai][0][m][1]; } }
                } }
    }
};
template <class Epi, class Sched, bool ALIGN_EPI = false, bool SP2 = false>
__device__ __forceinline__ void gemm_phase(LAS unsigned char* lds, const Gemm g, const Sched& S, const Epi& E) {
    const int tid = threadIdx.x, wid = __builtin_amdgcn_readfirstlane(tid >> 6), lane = tid & 63, wr = wid >> 2, wc = wid & 3, fr = lane & 15, fq = lane >> 4;
    const int K = g.K, nt = K / BK;
    unsigned voffA[2], voffB[2];
#pragma unroll
    for (int i = 0; i < 2; ++i) { int R, C; stage_rc(tid * 16 + i * 8192, R, C); const int Rb = Epi::PERM ? ((R & ~31) + perm32(R & 31)) : R;
        voffA[i] = (unsigned)(R * K + C) * 2u; voffB[i] = (unsigned)(Rb * K + C) * 2u; }
    const size_t kstep = (size_t)(BK * 2);
    const size_t hstep = (size_t)HALF * K * 2;
    const size_t tstep = 2 * hstep;
    const unsigned ldsw = (unsigned)wid * 1024u;
    const int aoff = lds_byte(wr * 64 + fr, fq * 8), boff = lds_byte(wc * 32 + fr, fq * 8);
#define PG8_SA(b, h) (((b) * 2 + (h)) * HTB)
#define PG8_SB(b, h) ((4 + (b) * 2 + (h)) * HTB)
#define PG8_STAGE(bufoff, gbase, voff) do { _Pragma("unroll") for (int _i = 0; _i < 2; ++_i) \
        __builtin_amdgcn_global_load_lds((const unsigned*)((const char*)(gbase) + (voff)[_i]), (LAS unsigned*)(lds + (bufoff) + ldsw + _i * 8192), 16, 0, 0); } while (0)
#define PG8_LDA(dst, b, h) do { _Pragma("unroll") for (int m = 0; m < 4; ++m) _Pragma("unroll") for (int k = 0; k < 2; ++k) dst[m][k] = *(const LAS h16x8*)(lds + PG8_SA(b, h) + aoff + m * 2048 + k * 1024); } while (0)
#define PG8_LDB(dst, b, h) do { _Pragma("unroll") for (int n = 0; n < 2; ++n) _Pragma("unroll") for (int k = 0; k < 2; ++k) dst[n][k] = *(const LAS h16x8*)(lds + PG8_SB(b, h) + boff + n * 2048 + k * 1024); } while (0)
#define PG8_MMA(ai, bj, At, Bt) do { __builtin_amdgcn_s_setprio(1); _Pragma("unroll") for (int m = 0; m < 4; ++m) _Pragma("unroll") for (int n = 0; n < 2; ++n) _Pragma("unroll") for (int k = 0; k < 2; ++k) \
        acc[ai][bj][m][n] = __builtin_amdgcn_mfma_f32_16x16x32_f16(Bt[n][k], At[m][k], acc[ai][bj][m][n], 0, 0, 0); __builtin_amdgcn_s_setprio(0); } while (0)
#define PG8_WAIT_V(n) asm volatile("s_waitcnt vmcnt(" #n ")" ::: "memory")
#define PG8_WAIT_L(n) asm volatile("s_waitcnt lgkmcnt(" #n ")" ::: "memory")
#define PG8_BAR __builtin_amdgcn_s_barrier()
#define PG8_SCHED __builtin_amdgcn_sched_barrier(0)
    Unit cur, nxt; int ui = 0;
    if (!S.next(0, cur)) return;
    f32x4 acc[2][2][4][2];
#pragma unroll
    for (int a = 0; a < 2; ++a)
#pragma unroll
        for (int b = 0; b < 2; ++b)
#pragma unroll
            for (int m = 0; m < 4; ++m)
#pragma unroll
                for (int n = 0; n < 2; ++n) acc[a][b][m][n] = (f32x4){0.f, 0.f, 0.f, 0.f};
    h16x8 At[4][2], B0[2][2], B1[2][2];
    const char* cA = (const char*)g.A + (size_t)cur.pm * tstep; const char* cB = (const char*)g.Bt + (size_t)cur.pn * tstep;
    S.a_ready(cur);
    if constexpr (SP2) {
        PG8_STAGE(PG8_SB(0, 0), cB, voffB); PG8_STAGE(PG8_SB(0, 1), cB + hstep, voffB); PG8_STAGE(PG8_SA(0, 0), cA, voffA); PG8_STAGE(PG8_SA(0, 1), cA + hstep, voffA);
        if (wr == 1) PG8_BAR;
        PG8_WAIT_V(2); PG8_BAR;
        PG8_STAGE(PG8_SB(1, 0), cB + kstep, voffB); PG8_STAGE(PG8_SA(1, 0), cA + kstep, voffA); PG8_STAGE(PG8_SB(1, 1), cB + hstep + kstep, voffB);
        PG8_WAIT_V(6); PG8_BAR;
    } else {
        PG8_STAGE(PG8_SB(0, 0), cB, voffB); PG8_STAGE(PG8_SA(0, 0), cA, voffA); PG8_STAGE(PG8_SB(0, 1), cB + hstep, voffB); PG8_STAGE(PG8_SA(0, 1), cA + hstep, voffA);
        if (wr == 1) PG8_BAR;
        PG8_WAIT_V(4); PG8_BAR;
        PG8_STAGE(PG8_SB(1, 0), cB + kstep, voffB); PG8_STAGE(PG8_SA(1, 0), cA + kstep, voffA); PG8_STAGE(PG8_SB(1, 1), cB + hstep + kstep, voffB);
        PG8_WAIT_V(6); PG8_BAR;
    }
    for (;;) {
        const bool has_next = S.next(ui + 1, nxt);
        const char* nA = has_next ? (const char*)g.A + (size_t)nxt.pm * tstep : cA; const char* nB = has_next ? (const char*)g.Bt + (size_t)nxt.pn * tstep : cB;
        for (int t = 0; t < nt; t += 2) {
            const bool last = (t == nt - 2);
            const char* a1 = cA + (size_t)(t + 1) * kstep;
            const char* a2 = last ? nA : cA + (size_t)(t + 2) * kstep; const char* b2 = last ? nB : cB + (size_t)(t + 2) * kstep;
            const char* a3 = a2 + kstep; const char* b3 = b2 + kstep;
            if (last && has_next) S.a_ready(nxt);
            if constexpr (SP2) {
            PG8_LDB(B0, 0, 0); PG8_LDB(B1, 0, 1); PG8_SCHED; PG8_LDA(At, 0, 0); PG8_STAGE(PG8_SA(1, 1), a1 + hstep, voffA);
            PG8_WAIT_V(8); PG8_WAIT_L(0); PG8_BAR; PG8_MMA(0, 0, At, B0); PG8_MMA(0, 1, At, B1); PG8_BAR; PG8_SCHED;
            PG8_LDA(At, 0, 1); PG8_STAGE(PG8_SB(0, 0), b2, voffB); PG8_STAGE(PG8_SB(0, 1), b2 + hstep, voffB); PG8_STAGE(PG8_SA(0, 0), a2, voffA);
            PG8_WAIT_V(8); PG8_WAIT_L(0); PG8_BAR; PG8_MMA(1, 0, At, B0); PG8_MMA(1, 1, At, B1); PG8_BAR; PG8_SCHED;
            PG8_LDB(B0, 1, 0); PG8_LDB(B1, 1, 1); PG8_SCHED; PG8_LDA(At, 1, 0); PG8_STAGE(PG8_SA(0, 1), a2 + hstep, voffA);
            PG8_WAIT_V(8); PG8_WAIT_L(0); PG8_BAR; PG8_MMA(0, 0, At, B0); PG8_MMA(0, 1, At, B1); PG8_BAR; PG8_SCHED;
            PG8_LDA(At, 1, 1); PG8_STAGE(PG8_SB(1, 0), b3, voffB); PG8_STAGE(PG8_SB(1, 1), b3 + hstep, voffB); PG8_STAGE(PG8_SA(1, 0), a3, voffA);
            PG8_WAIT_V(8); PG8_WAIT_L(0); PG8_BAR; PG8_MMA(1, 0, At, B0); PG8_MMA(1, 1, At, B1); PG8_BAR; PG8_SCHED;
            } else {
            PG8_LDB(B0, 0, 0); PG8_SCHED; PG8_LDA(At, 0, 0); PG8_STAGE(PG8_SA(1, 1), a1 + hstep, voffA);
            PG8_WAIT_L(8); PG8_BAR; PG8_WAIT_L(0); PG8_MMA(0, 0, At, B0); PG8_BAR; PG8_SCHED;
            PG8_LDB(B1, 0, 1); PG8_STAGE(PG8_SB(0, 0), b2, voffB);
            PG8_BAR; PG8_WAIT_L(0); PG8_MMA(0, 1, At, B1); PG8_BAR;
            PG8_LDA(At, 0, 1); PG8_STAGE(PG8_SA(0, 0), a2, voffA);
            PG8_BAR; PG8_WAIT_L(0); PG8_MMA(1, 0, At, B0); PG8_BAR; PG8_SCHED;
            PG8_STAGE(PG8_SB(0, 1), b2 + hstep, voffB);
            PG8_WAIT_V(6); PG8_BAR; PG8_MMA(1, 1, At, B1); PG8_BAR;
            PG8_LDB(B0, 1, 0); PG8_SCHED; PG8_LDA(At, 1, 0); PG8_STAGE(PG8_SA(0, 1), a2 + hstep, voffA);
            PG8_WAIT_L(8); PG8_BAR; PG8_WAIT_L(0); PG8_MMA(0, 0, At, B0); PG8_BAR; PG8_SCHED;
            PG8_LDB(B1, 1, 1); PG8_STAGE(PG8_SB(1, 0), b3, voffB);
            PG8_BAR; PG8_WAIT_L(0); PG8_MMA(0, 1, At, B1); PG8_BAR;
            PG8_LDA(At, 1, 1); PG8_STAGE(PG8_SA(1, 0), a3, voffA);
            PG8_BAR; PG8_WAIT_L(0); PG8_MMA(1, 0, At, B0); PG8_BAR; PG8_SCHED;
            PG8_STAGE(PG8_SB(1, 1), b3 + hstep, voffB);
            PG8_WAIT_V(6); PG8_BAR; PG8_MMA(1, 1, At, B1); PG8_BAR;
            }
        }
        if constexpr (ALIGN_EPI) { if (wr == 0) PG8_BAR; }
        if constexpr (!Epi::AFTER_DRAIN) { E(acc, cur, wr, wc, fr, fq); S.done(cur); }
        if (!has_next) break;
#pragma unroll
        for (int a = 0; a < 2; ++a)
#pragma unroll
            for (int b = 0; b < 2; ++b)
#pragma unroll
                for (int m = 0; m < 4; ++m)
#pragma unroll
                    for (int n = 0; n < 2; ++n) acc[a][b][m][n] = (f32x4){0.f, 0.f, 0.f, 0.f};
        cur = nxt; cA = nA; cB = nB; ++ui;
        if constexpr (ALIGN_EPI) { if (wr == 1) PG8_BAR; }
    }
    PG8_WAIT_V(0);
    if constexpr (!ALIGN_EPI) { if (wr == 0) PG8_BAR; }
    PG8_BAR;
    if constexpr (Epi::AFTER_DRAIN) { E.fused(acc, cur, wr, wc, fr, fq, lds, wid, lane); S.done(cur); }
#undef PG8_SA
#undef PG8_SB
#undef PG8_STAGE
#undef PG8_LDA
#undef PG8_LDB
#undef PG8_MMA
#undef PG8_WAIT_V
#undef PG8_WAIT_L
#undef PG8_BAR
#undef PG8_SCHED
}
}

#define XB_TMO      128
#define XB_XCNT(j)  (256  + 64 * (j))
#define XB_XSUB(j)  (1280 + 64 * (j))
#define XB_XGEN(j)  (2304 + 64 * (j))
#define XB_TOP      3328
#define XB_TOPGEN   3392
#define XCD_BAR_WORDS 3456
#define XB_SPIN_CAP (1u << 22)
__device__ __forceinline__ unsigned xb_ld(unsigned* p)              { return __hip_atomic_load(p, __ATOMIC_RELAXED, __HIP_MEMORY_SCOPE_AGENT); }
__device__ __forceinline__ unsigned xb_add(unsigned* p, unsigned v) { return __hip_atomic_fetch_add(p, v, __ATOMIC_RELAXED, __HIP_MEMORY_SCOPE_AGENT); }
__device__ __forceinline__ unsigned xb_xcc_id() { return (unsigned)__builtin_amdgcn_s_getreg((3 << 11) | 20) & 0xFu; }
#define XB_SPIN(cond, bar) do { unsigned _sp = 0; while (cond) { __builtin_amdgcn_s_sleep(1); \
    if ((++_sp & 255u) == 0u) { if (xb_ld(&(bar)[XB_TMO])) break; if (_sp > XB_SPIN_CAP) { atomicAdd(&(bar)[XB_TMO], 1u); break; } } } } while (0)
struct XcdBarrier { unsigned* bar; unsigned x; volatile LAS unsigned* st; };
__device__ __forceinline__ XcdBarrier xcd_barrier_post(unsigned* bar, volatile LAS unsigned* st) {
    XcdBarrier b; b.bar = bar; b.x = xb_xcc_id(); b.st = st;
    if (threadIdx.x == 0) (void)xb_add(&bar[XB_XCNT(b.x)], 1u);
    return b;
}
__device__ __forceinline__ void xcd_barrier_complete(unsigned* bar, unsigned x, unsigned& nloc, unsigned& nx) {
    const unsigned G = gridDim.x * gridDim.y * gridDim.z;
    unsigned sum, cnt, mine, sp = 0u;
    for (;;) {
        sum = 0u; cnt = 0u; mine = 0u;
#pragma unroll
        for (unsigned j = 0; j < 16; ++j) { const unsigned c = xb_ld(&bar[XB_XCNT(j)]); sum += c; cnt += (c > 0u) ? 1u : 0u; mine = (j == x) ? c : mine; }
        if (sum == G) break;
        __builtin_amdgcn_s_sleep(1);
        if ((++sp & 255u) == 0u) { if (xb_ld(&bar[XB_TMO])) break; if (sp > XB_SPIN_CAP) { atomicAdd(&bar[XB_TMO], 1u); break; } }
    }
    nloc = mine > 0u ? mine : 1u; nx = cnt > 0u ? cnt : 1u;
}
__device__ __forceinline__ void xcd_barrier(const XcdBarrier& b) {
    asm volatile("s_waitcnt vmcnt(0)" ::: "memory");
    __syncthreads();
    if (threadIdx.x == 0) {
        unsigned* bar = b.bar;
        __builtin_amdgcn_s_waitcnt(0);
        unsigned nloc = b.st[0], nx = b.st[1];
        if (nloc == 0u) { xcd_barrier_complete(bar, b.x, nloc, nx); b.st[0] = nloc; b.st[1] = nx; }
        const unsigned old = xb_add(&bar[XB_XSUB(b.x)], 1u);
        const unsigned gen = old / nloc;
        if (old + 1u == (gen + 1u) * nloc) {
            __builtin_amdgcn_fence(__ATOMIC_RELEASE, "agent");
            asm volatile("s_waitcnt vmcnt(0)" ::: "memory");
            const unsigned og = xb_add(&bar[XB_TOP], 1u);
            const unsigned tg = og / nx;
            if (og + 1u == (tg + 1u) * nx) xb_add(&bar[XB_TOPGEN], 1u);
            else XB_SPIN(xb_ld(&bar[XB_TOPGEN]) == tg, bar);
            __builtin_amdgcn_fence(__ATOMIC_ACQUIRE, "agent");
            xb_add(&bar[XB_XGEN(b.x)], 1u);
            asm volatile("s_waitcnt vmcnt(0)" ::: "memory");
        } else {
            XB_SPIN(xb_ld(&bar[XB_XGEN(b.x)]) == gen, bar);
            __builtin_amdgcn_fence(__ATOMIC_ACQUIRE, "agent");
            asm volatile("s_waitcnt vmcnt(0)" ::: "memory");
        }
    }
    __syncthreads();
}

constexpr int NWAVES = 8, NTHR = NWAVES * 64;
constexpr int RING_BYTES = 131072, MISC_OFF = RING_BYTES, AUX_OFF = MISC_OFF + 256, LDS_BYTES = 147456;
constexpr size_t WS_MODP = WS_MOD + 64 * 1024;
constexpr int CW_BAR = 1024;
constexpr int MAX_LAUNCH = 8;
constexpr size_t CTL_ZERO_BYTES = (size_t)(CW_BAR + MAX_LAUNCH * XCD_BAR_WORDS) * 4;
#define LDS_WAIT() asm volatile("s_waitcnt lgkmcnt(0)" ::: "memory")

struct Args { const float* in[20]; float* out; unsigned char* ws; int ph_lo, ph_hi, li, pad; };
enum { I_X = 0, I_C, I_WADA, I_BADA, I_N1PRE, I_N1POST, I_WIN, I_CONVW, I_CONVB, I_DTB, I_ALOG, I_DSKIP, I_SSMN, I_RELB, I_ATTN, I_WOUT, I_N2PRE, I_N2POST, I_W1, I_W2 };

template <int MODE> __device__ __forceinline__ void p0_transpose_item(const float* W, int K, int N, h16* WT, LAS float* scr, int item, int nblk, int lane) {
    const int kb = item / nblk, nb = item % nblk, k0 = 64 * kb, n0 = 32 * nb;
    const int sc = MODE ? win_src(n0 + (lane & 31)) : n0 + (lane & 31);
#pragma unroll 8
    for (int i = 0; i < 32; ++i) { const int kk = 2 * i + (lane >> 5); scr[kk * 33 + (lane & 31)] = sc >= 0 ? W[(size_t)(k0 + kk) * N + sc] : 0.f; }
    LDS_WAIT(); asm volatile("" ::: "memory");
    const int c = lane & 7;
#pragma unroll
    for (int j = 0; j < 4; ++j) { const int n = (lane >> 3) + 8 * j; const LAS float* s = scr + (8 * c) * 33 + n;
        u32x4 o; o.x = pk_h2(s[0 * 33], s[1 * 33]); o.y = pk_h2(s[2 * 33], s[3 * 33]); o.z = pk_h2(s[4 * 33], s[5 * 33]); o.w = pk_h2(s[6 * 33], s[7 * 33]);
        *(u32x4*)(WT + (size_t)(n0 + n) * K + k0 + 8 * c) = o; }
    LDS_WAIT(); asm volatile("" ::: "memory");
}

__global__ void __launch_bounds__(NTHR, 2) mk_fwd(Args args) {
    extern __shared__ __attribute__((aligned(16))) unsigned char lds_raw[];
    LAS unsigned char* lds = (LAS unsigned char*)lds_raw;
    volatile LAS unsigned* MISC = (volatile LAS unsigned*)(lds + MISC_OFF);
    const int tid = threadIdx.x, lane = tid & 63, wave = __builtin_amdgcn_readfirstlane(tid >> 6);
    const int G = gridDim.x, bx = blockIdx.x, gw = bx * NWAVES + wave, NGW = G * NWAVES;
    unsigned char* ws = args.ws;
    unsigned* ctl = (unsigned*)(ws + WS_CTL);
    const float* x = args.in[I_X]; float* out = args.out;
    float* MOD = (float*)(ws + WS_MOD); float* MODP = (float*)(ws + WS_MODP); float* PF32 = (float*)(ws + WS_PF32);
    h16* WIN = (h16*)(ws + WS_WIN); h16* WOUT = (h16*)(ws + WS_WOUT); h16* W1 = (h16*)(ws + WS_W1); h16* W2 = (h16*)(ws + WS_W2);
    h16* XN = (h16*)(ws + WS_XN); h16* PROJ = (h16*)(ws + WS_PROJ); h16* MIX = (h16*)(ws + WS_MIX);
    float* MIXO = (float*)(ws + WS_MIXO); h16* HB = (h16*)(ws + WS_H); float* FB = (float*)(ws + WS_F);
    if (tid < 64) MISC[tid] = 0u;
    __syncthreads();
    XcdBarrier bar = xcd_barrier_post(ctl + CW_BAR + args.li * XCD_BAR_WORDS, MISC + 8);
    const int lo = args.ph_lo, hi = args.ph_hi;
#define IN(k) (lo <= (k) && (k) < hi)
#define SEAM(k) do { if (IN(k) && IN((k) + 1)) xcd_barrier(bar); } while (0)

    if (IN(0)) {
        LAS float* scr = (LAS float*)(lds + wave * 16384);
        constexpr int I_IN = 16 * 96, I_O = 16 * 32, I_1 = 16 * 128, I_2 = 64 * 32, I_M = 96 * 16, NITEMS = I_IN + I_O + I_1 + I_2 + I_M;
        for (int it = gw; it < NITEMS; it += NGW) {
            int r = it;
            if (r < I_IN) { p0_transpose_item<1>(args.in[I_WIN], D, 2896, WIN, scr, r, 96, lane); continue; } r -= I_IN;
            if (r < I_O) { p0_transpose_item<0>(args.in[I_WOUT], D, D, WOUT, scr, r, 32, lane); continue; } r -= I_O;
            if (r < I_1) { p0_transpose_item<0>(args.in[I_W1], D, FF, W1, scr, r, 128, lane); continue; } r -= I_1;
            if (r < I_2) { p0_transpose_item<0>(args.in[I_W2], FF, D, W2, scr, r, 32, lane); continue; } r -= I_2;
            const int cg = r % 96, ks = r / 96, jj = cg * 64 + lane, k0 = ks * 64;
            const float s0 = silu_f(args.in[I_C][k0 + lane]), s1 = silu_f(args.in[I_C][D + k0 + lane]);
            const float* wp = args.in[I_WADA] + (size_t)k0 * (6 * D) + jj; float a0 = 0.f, a1 = 0.f;
#pragma unroll 16
            for (int kk = 0; kk < 64; ++kk) { const float w = wp[(size_t)kk * (6 * D)]; a0 += __shfl(s0, kk) * w; a1 += __shfl(s1, kk) * w; }
            MODP[(size_t)(ks * 2 + 0) * (6 * D) + jj] = a0; MODP[(size_t)(ks * 2 + 1) * (6 * D) + jj] = a1;
        }
    }
    SEAM(0);
    if (IN(1)) {
        for (int i = bx * NTHR + tid; i < NB * 6 * D; i += G * NTHR) { const int b = i / (6 * D), jj = i % (6 * D); float a = args.in[I_BADA][jj];
#pragma unroll
            for (int ks = 0; ks < 16; ++ks) a += MODP[(size_t)(ks * 2 + b) * (6 * D) + jj];
            MOD[i] = a; }
        LAS float* mv = (LAS float*)lds;
        for (int i = tid; i < NB * 2 * D; i += NTHR) { const int b = i / (2 * D), jj = i % (2 * D); float a = args.in[I_BADA][jj];
#pragma unroll
            for (int ks = 0; ks < 16; ++ks) a += MODP[(size_t)(ks * 2 + b) * (6 * D) + jj];
            mv[i] = a; }
        __syncthreads();
        const float* g1 = args.in[I_N1PRE];
        for (int m = gw; m < M; m += NGW) {
            const int b = m / T; const f32x4* xr = (const f32x4*)(x + (size_t)m * D) + lane; f32x4 v[4]; float ss = 0.f;
#pragma unroll
            for (int j = 0; j < 4; ++j) { v[j] = xr[64 * j]; ss += (v[j].x * v[j].x + v[j].y * v[j].y) + (v[j].z * v[j].z + v[j].w * v[j].w); }
            const float rstd = rsqrtf(wave_sum(ss) * (1.f / D) + EPS);
            u32x2* o8 = (u32x2*)(XN + (size_t)m * D) + lane;
#pragma unroll
            for (int j = 0; j < 4; ++j) { const int k = 4 * lane + 256 * j; const f32x4 gg = *(const f32x4*)(g1 + k);
                const f32x4 sh = *(const LAS f32x4*)(mv + b * 2 * D + k), sc = *(const LAS f32x4*)(mv + b * 2 * D + D + k);
                const f32x4 r = v[j] * rstd * gg * (sc + 1.f) + sh; u32x2 w; w.x = pk_h2(r.x, r.y); w.y = pk_h2(r.z, r.w); o8[64 * j] = w; }
        }
        __syncthreads();
    }
    SEAM(1);
    if (IN(2)) {
        pg8::Gemm g{XN, WIN, M, NPROJ, D}; pg8::StaticOrder S; S.init(M, NPROJ, G, bx);
        pg8::EpiH16<0, true> E{PROJ, NPROJ, PF32};
        pg8::gemm_phase<pg8::EpiH16<0, true>, pg8::StaticOrder, true, true>(lds, g, S, E);
    }
    SEAM(2);
    if (IN(3)) {
        LAS h16* raw = (LAS h16*)(lds + wave * 16384);
        constexpr int N_CONV = NB * 128 * 16, N_SCAN = NB * 32 * 8;
        for (int it = gw; it < N_CONV + N_SCAN; it += NGW) {
            if (it < N_CONV) {
                const int cb = it & 15, tb = (it >> 4) & 127, b = it >> 11, t0 = tb * 64; const size_t m0 = (size_t)b * T + t0;
#pragma unroll
                for (int i = 0; i < 9; ++i) { const int row = (lane >> 3) + 8 * i, ch = lane & 7; u32x4 v = {0u, 0u, 0u, 0u};
                    if (row < 67 && t0 - 3 + row >= 0) v = *(const u32x4*)(PROJ + (m0 - 3 + row) * NPROJ + C_XBC + cb * 64 + ch * 8);
                    *(LAS u32x4*)(raw + row * 64 + ch * 8) = v; }
                LDS_WAIT(); asm volatile("" ::: "memory");
                const int chn = cb * 64 + lane;
                const float w0 = args.in[I_CONVW][chn], w1 = args.in[I_CONVW][1024 + chn], w2 = args.in[I_CONVW][2048 + chn], w3 = args.in[I_CONVW][3072 + chn], cbias = args.in[I_CONVB][chn];
                float r0 = (float)raw[lane], r1 = (float)raw[64 + lane], r2 = (float)raw[128 + lane];
                unsigned yp[32];
#pragma unroll
                for (int t = 0; t < 64; t += 2) {
                    const float r3 = (float)raw[(t + 3) * 64 + lane], r4 = (float)raw[(t + 4) * 64 + lane];
                    const float a0 = cbias + w0 * r0 + w1 * r1 + w2 * r2 + w3 * r3, a1 = cbias + w0 * r1 + w1 * r2 + w2 * r3 + w3 * r4;
                    const float y0 = a0 * __builtin_amdgcn_rcpf(1.f + __expf(-a0)), y1 = a1 * __builtin_amdgcn_rcpf(1.f + __expf(-a1));
                    yp[t >> 1] = pk_h2(y0, y1);
                    raw[t * 64 + lane] = (h16)y0; raw[(t + 1) * 64 + lane] = (h16)y1;
                    r0 = r2; r1 = r3; r2 = r4;
                }
                LDS_WAIT(); asm volatile("" ::: "memory");
                h16* xc = (h16*)((unsigned char*)out + DO_XC);
#pragma unroll
                for (int i = 0; i < 8; ++i) { const int row = (lane >> 3) + 8 * i, ch = lane & 7;
                    *(u32x4*)(xc + (m0 + row) * 1024 + cb * 64 + ch * 8) = *(const LAS u32x4*)(raw + row * 64 + ch * 8); }
                if (cb < 12) {
                    h16* dst = cb < 8 ? (h16*)((unsigned char*)out + DO_XST) + ((size_t)(b * 8 + cb) * 64 + lane) * T + t0
                                      : (h16*)((unsigned char*)out + DO_BT) + ((size_t)(b * 2 + ((cb - 8) >> 1)) * 128 + ((cb - 8) & 1) * 64 + lane) * T + t0;
#pragma unroll
                    for (int i = 0; i < 8; ++i) { u32x4 v = {yp[4 * i], yp[4 * i + 1], yp[4 * i + 2], yp[4 * i + 3]}; *(u32x4*)(dst + 8 * i) = v; }
                }
                LDS_WAIT(); asm volatile("" ::: "memory");
            } else {
                const int r = it - N_CONV, h = r & 7, c = (r >> 3) & 31, b = r >> 8; const size_t m = (size_t)b * T + c * 256 + 4 * lane;
                const float a = -__expf(args.in[I_ALOG][h]), bias = args.in[I_DTB][h];
                f32x4 dt, cs; float run = 0.f;
#pragma unroll
                for (int j = 0; j < 4; ++j) { dt[j] = softplus_f(PF32[(m + j) * 16 + h] + bias); run += a * dt[j]; cs[j] = run; }
                float incl = run;
#pragma unroll
                for (int o = 1; o < 64; o <<= 1) { const float u = __shfl_up(incl, o); if (lane >= o) incl += u; }
                const float excl = incl - run;
                float* DTp = (float*)(ws + WS_DT); float* ACSp = (float*)(ws + WS_ACS); const size_t o4 = (size_t)(b * 8 + h) * T + c * 256 + 4 * lane;
                *(f32x4*)(DTp + o4) = dt; *(f32x4*)(ACSp + o4) = cs + excl;
            }
        }
    }
    SEAM(3);
    if (IN(4)) {
        LAS float* wtab = (LAS float*)lds;
        const h16* XST = (const h16*)((unsigned char*)out + DO_XST); const h16* BT = (const h16*)((unsigned char*)out + DO_BT);
        const float* DTp = (const float*)(ws + WS_DT); const float* ACSp = (const float*)(ws + WS_ACS); float* ST = (float*)(ws + WS_STATES);
        const int r = lane & 31, hh = lane >> 5, pt = wave & 1, ntile = wave >> 1;
        for (int u = bx; u < NB * 32 * 8; u += G) {
            const int h = u & 7, c = (u >> 3) & 31, b = u >> 8, g = h >> 2; const size_t tb = (size_t)(b * 8 + h) * T + c * 256;
            if (tid < 256) wtab[tid] = DTp[tb + tid] * __expf(ACSp[tb + 255] - ACSp[tb + tid]);
            __syncthreads();
            f32x16 acc;
#pragma unroll
            for (int i = 0; i < 16; ++i) acc[i] = 0.f;
            const h16* ap = XST + ((size_t)(b * 8 + h) * 64 + pt * 32 + r) * T + c * 256 + 8 * hh;
            const h16* bp = BT + ((size_t)(b * 2 + g) * 128 + ntile * 32 + r) * T + c * 256 + 8 * hh;
#pragma unroll 4
            for (int ks = 0; ks < 16; ++ks) {
                const h16x8 A = *(const h16x8*)(ap + 16 * ks), Bv = *(const h16x8*)(bp + 16 * ks);
                const f32x4 wa = *(const LAS f32x4*)(wtab + 16 * ks + 8 * hh), wb = *(const LAS f32x4*)(wtab + 16 * ks + 8 * hh + 4);
                h16x8 Bs;
#pragma unroll
                for (int j = 0; j < 4; ++j) { Bs[j] = (h16)((float)Bv[j] * wa[j]); Bs[4 + j] = (h16)((float)Bv[4 + j] * wb[j]); }
                acc = __builtin_amdgcn_mfma_f32_32x32x16_f16(A, Bs, acc, 0, 0, 0);
            }
            float* sp = ST + ((size_t)((b * 32 + c) * 8 + h) * 64 + pt * 32) * 128 + ntile * 32 + r;
#pragma unroll
            for (int i = 0; i < 16; ++i) sp[(size_t)((i & 3) + 8 * (i >> 2) + 4 * hh) * 128] = acc[i];
            __syncthreads();
        }
    }
    SEAM(4);
    if (IN(5)) {
        const float* ACSp = (const float*)(ws + WS_ACS); const float* ST = (const float*)(ws + WS_STATES); h16* PV = (h16*)(ws + WS_PREV);
        for (int e = bx * NTHR + tid; e < NB * 8 * 64 * 128; e += G * NTHR) {
            const int pn = e & 8191, h = (e >> 13) & 7, b = e >> 16; float hs = 0.f;
            float sv[32];
#pragma unroll
            for (int c = 0; c < 32; ++c) sv[c] = ST[(size_t)((b * 32 + c) * 8 + h) * 8192 + pn];
#pragma unroll
            for (int c = 0; c < 32; ++c) { PV[(size_t)((b * 32 + c) * 8 + h) * 8192 + pn] = (h16)hs; hs = hs * __expf(ACSp[(size_t)(b * 8 + h) * T + c * 256 + 255]) + sv[c]; }
        }
    }
    SEAM(5);
    if (IN(6)) {
        LAS float* acs_tab = (LAS float*)lds; LAS float* dt_tab = acs_tab + 2048; LAS float* part = dt_tab + 2048;
        const h16* XC = (const h16*)((unsigned char*)out + DO_XC); const h16* XST = (const h16*)((unsigned char*)out + DO_XST);
        const float* DTp = (const float*)(ws + WS_DT); const float* ACSp = (const float*)(ws + WS_ACS); const h16* PV = (const h16*)(ws + WS_PREV);
        const int r = lane & 31, hh = lane >> 5, h = wave, g = h >> 2; const float dsk = args.in[I_DSKIP][h];
        for (int i = 0;; ++i) {
            const int j = i * G + bx; if (j >= NB * 32 * 8) break;
            const int bc = j >> 3, lbr = j & 7, lb = (i & 1) ? 7 - lbr : lbr, b = bc >> 5, c = bc & 31, t0 = c * 256;
            for (int k = tid; k < 2048; k += NTHR) { const size_t o = (size_t)(b * 8 + (k >> 8)) * T + t0 + (k & 255); acs_tab[k] = ACSp[o]; dt_tab[k] = DTp[o]; }
            __syncthreads();
            const int l = lb * 32 + r; const size_t ml = (size_t)b * T + t0 + l; const float acs_l = acs_tab[h * 256 + l];
            h16x8 Cf[8];
#pragma unroll
            for (int ks = 0; ks < 8; ++ks) Cf[ks] = *(const h16x8*)(XC + ml * 1024 + 768 + g * 128 + 16 * ks + 8 * hh);
            f32x16 Y[2];
#pragma unroll
            for (int q = 0; q < 16; ++q) { Y[0][q] = 0.f; Y[1][q] = 0.f; }
            const h16* xst = XST + ((size_t)(b * 8 + h) * 64 + r) * T + t0 + 4 * hh;
            for (int sb = 0; sb <= lb; ++sb) {
                const size_t ms = (size_t)b * T + t0 + sb * 32 + r;
                f32x16 Dv;
#pragma unroll
                for (int q = 0; q < 16; ++q) Dv[q] = 0.f;
#pragma unroll
                for (int ks = 0; ks < 8; ++ks) { const h16x8 Bf = *(const h16x8*)(XC + ms * 1024 + 512 + g * 128 + 16 * ks + 8 * hh); Dv = __builtin_amdgcn_mfma_f32_32x32x16_f16(Bf, Cf[ks], Dv, 0, 0, 0); }
                h16x8 Mf[2];
#pragma unroll
                for (int q = 0; q < 4; ++q) { const int sl = sb * 32 + 8 * q + 4 * hh;
                    const f32x4 as = *(const LAS f32x4*)(acs_tab + h * 256 + sl), ds = *(const LAS f32x4*)(dt_tab + h * 256 + sl);
#pragma unroll
                    for (int e = 0; e < 4; ++e) { float v = Dv[4 * q + e] * __expf(acs_l - as[e]) * ds[e]; if (sl + e > l) v = 0.f; Mf[q >> 1][(q & 1) * 4 + e] = (h16)v; } }
#pragma unroll
                for (int s2 = 0; s2 < 2; ++s2)
#pragma unroll
                    for (int pt = 0; pt < 2; ++pt) { const h16* ap = xst + (size_t)(pt * 32) * T + sb * 32 + 16 * s2;
                        const h16x4 lo = *(const h16x4*)ap, hi = *(const h16x4*)(ap + 8);
                        const h16x8 A = {lo[0], lo[1], lo[2], lo[3], hi[0], hi[1], hi[2], hi[3]};
                        Y[pt] = __builtin_amdgcn_mfma_f32_32x32x16_f16(A, Mf[s2], Y[pt], 0, 0, 0); }
            }
            {
                f32x16 O[2];
#pragma unroll
                for (int q = 0; q < 16; ++q) { O[0][q] = 0.f; O[1][q] = 0.f; }
                const h16* pv = PV + ((size_t)((b * 32 + c) * 8 + h) * 64 + r) * 128 + 8 * hh;
#pragma unroll
                for (int ks = 0; ks < 8; ++ks)
#pragma unroll
                    for (int pt = 0; pt < 2; ++pt) { const h16x8 A = *(const h16x8*)(pv + (size_t)(pt * 32) * 128 + 16 * ks); O[pt] = __builtin_amdgcn_mfma_f32_32x32x16_f16(A, Cf[ks], O[pt], 0, 0, 0); }
                const float el = __expf(acs_l);
#pragma unroll
                for (int q = 0; q < 16; ++q) { Y[0][q] += O[0][q] * el; Y[1][q] += O[1][q] * el; }
            }
            float ss = 0.f;
#pragma unroll
            for (int pt = 0; pt < 2; ++pt)
#pragma unroll
                for (int q = 0; q < 4; ++q) { const int p0 = h * 64 + pt * 32 + 8 * q + 4 * hh;
                    const h16x4 xv = *(const h16x4*)(XC + ml * 1024 + p0), zv = *(const h16x4*)(PROJ + ml * NPROJ + C_Z + p0);
#pragma unroll
                    for (int e = 0; e < 4; ++e) { const float z = (float)zv[e]; const float u = (Y[pt][4 * q + e] + dsk * (float)xv[e]) * (z * __builtin_amdgcn_rcpf(1.f + __expf(-z))); Y[pt][4 * q + e] = u; ss += u * u; } }
            ss += __shfl_xor(ss, 32);
            if (hh == 0) part[h * 32 + r] = ss;
            __syncthreads();
            float tot = 0.f;
#pragma unroll
            for (int w = 0; w < 8; ++w) tot += part[w * 32 + r];
            const float rstd = rsqrtf(tot * (1.f / 512.f) + EPS);
#pragma unroll
            for (int pt = 0; pt < 2; ++pt)
#pragma unroll
                for (int q = 0; q < 4; ++q) { const int p0 = h * 64 + pt * 32 + 8 * q + 4 * hh; const f32x4 wv = *(const f32x4*)(args.in[I_SSMN] + p0);
                    u32x2 o; o.x = pk_h2(Y[pt][4 * q] * rstd * wv[0], Y[pt][4 * q + 1] * rstd * wv[1]); o.y = pk_h2(Y[pt][4 * q + 2] * rstd * wv[2], Y[pt][4 * q + 3] * rstd * wv[3]);
                    *(u32x2*)(MIX + ml * D + p0) = o; }
            __syncthreads();
        }
    }
    SEAM(6);
    if (IN(9)) {
        pg8::Gemm g{MIX, WOUT, M, D, D}; pg8::StaticOrder S; S.init(M, D, G, bx);
        pg8::EpiF32 E{MIXO, D};
        pg8::gemm_phase<pg8::EpiF32, pg8::StaticOrder, true, true>(lds, g, S, E);
    }
    SEAM(9);
    if (IN(10)) {
        const float* w1p = args.in[I_N1POST]; const float* w2p = args.in[I_N2PRE];
        for (int m = gw; m < M; m += NGW) {
            const int b = m / T; const float* md = MOD + (size_t)b * 6 * D; const f32x4* mr = (const f32x4*)(MIXO + (size_t)m * D) + lane; const f32x4* xr = (const f32x4*)(x + (size_t)m * D) + lane;
            f32x4 v[4]; float ss = 0.f;
#pragma unroll
            for (int j = 0; j < 4; ++j) { v[j] = mr[64 * j]; ss += (v[j].x * v[j].x + v[j].y * v[j].y) + (v[j].z * v[j].z + v[j].w * v[j].w); }
            float rstd = rsqrtf(wave_sum(ss) * (1.f / D) + EPS); ss = 0.f;
            f32x4* orow = (f32x4*)(out + (size_t)m * D) + lane;
#pragma unroll
            for (int j = 0; j < 4; ++j) { const int k = 4 * lane + 256 * j; const f32x4 gt = *(const f32x4*)(md + 2 * D + k), wp = *(const f32x4*)(w1p + k);
                v[j] = xr[64 * j] + gt * (v[j] * rstd * wp); orow[64 * j] = v[j]; ss += (v[j].x * v[j].x + v[j].y * v[j].y) + (v[j].z * v[j].z + v[j].w * v[j].w); }
            rstd = rsqrtf(wave_sum(ss) * (1.f / D) + EPS);
            u32x2* o8 = (u32x2*)(XN + (size_t)m * D) + lane;
#pragma unroll
            for (int j = 0; j < 4; ++j) { const int k = 4 * lane + 256 * j; const f32x4 gg = *(const f32x4*)(w2p + k), sh = *(const f32x4*)(md + 3 * D + k), sc = *(const f32x4*)(md + 4 * D + k);
                const f32x4 r = v[j] * rstd * gg * (sc + 1.f) + sh; u32x2 w; w.x = pk_h2(r.x, r.y); w.y = pk_h2(r.z, r.w); o8[64 * j] = w; }
        }
    }
    SEAM(10);
    if (IN(11)) {
        pg8::Gemm g{XN, W1, M, FF, D}; pg8::StaticOrder S; S.init(M, FF, G, bx);
        pg8::EpiH16<1, false> E{HB, FF, nullptr};
        pg8::gemm_phase<pg8::EpiH16<1, false>, pg8::StaticOrder, true, true>(lds, g, S, E);
    }
    SEAM(11);
    if (IN(12)) {
        pg8::Gemm g{HB, W2, M, D, FF}; pg8::StaticOrder S; S.init(M, D, G, bx);
        pg8::EpiF32 E{FB, D};
        pg8::gemm_phase<pg8::EpiF32, pg8::StaticOrder, true, true>(lds, g, S, E);
    }
    SEAM(12);
    if (IN(13)) {
        const float* w2post = args.in[I_N2POST];
        for (int m = gw; m < M; m += NGW) {
            const int b = m / T; const float* md = MOD + (size_t)b * 6 * D; const f32x4* fr = (const f32x4*)(FB + (size_t)m * D) + lane;
            f32x4 v[4]; float ss = 0.f;
#pragma unroll
            for (int j = 0; j < 4; ++j) { v[j] = fr[64 * j]; ss += (v[j].x * v[j].x + v[j].y * v[j].y) + (v[j].z * v[j].z + v[j].w * v[j].w); }
            const float rstd = rsqrtf(wave_sum(ss) * (1.f / D) + EPS);
            f32x4* orow = (f32x4*)(out + (size_t)m * D) + lane;
#pragma unroll
            for (int j = 0; j < 4; ++j) { const int k = 4 * lane + 256 * j; const f32x4 gt = *(const f32x4*)(md + 5 * D + k), wp = *(const f32x4*)(w2post + k);
                orow[64 * j] = orow[64 * j] + gt * (v[j] * rstd * wp); }
        }
    }
#undef IN
#undef SEAM
}

static int g_grid = 0;
static void mk_launch(Args& a, int lo, int hi, int li, hipStream_t stream) {
    a.ph_lo = lo; a.ph_hi = hi; a.li = li;
    hipLaunchKernelGGL(mk_fwd, dim3(g_grid), dim3(NTHR), LDS_BYTES, stream, a);
}

extern "C" void kernel_launch(void* const* d_in, const int* in_sizes, int n_in, void* d_out, int out_size, void* d_ws, size_t ws_size, hipStream_t stream) {
    const float* x = (const float*)d_in[0]; const float* c = (const float*)d_in[1]; const float* w_ada = (const float*)d_in[2]; const float* b_ada = (const float*)d_in[3];
    const float* norm1_pre = (const float*)d_in[4]; const float* norm1_post = (const float*)d_in[5]; const float* w_in = (const float*)d_in[6];
    const float* conv_w = (const float*)d_in[7]; const float* conv_b = (const float*)d_in[8]; const float* dt_bias = (const float*)d_in[9];
    const float* a_log = (const float*)d_in[10]; const float* d_skip = (const float*)d_in[11]; const float* ssm_norm = (const float*)d_in[12];
    const float* rel_bias = (const float*)d_in[13]; const float* attn_norm = (const float*)d_in[14]; const float* w_out = (const float*)d_in[15];
    const float* norm2_pre = (const float*)d_in[16]; const float* norm2_post = (const float*)d_in[17]; const float* w_mlp_in = (const float*)d_in[18]; const float* w_mlp_out = (const float*)d_in[19];
    unsigned char* ws = (unsigned char*)d_ws; unsigned char* dob = (unsigned char*)d_out; float* out = (float*)d_out;
    float* MOD = (float*)(ws + WS_MOD); float* PF32 = (float*)(ws + WS_PF32);
    h16* WIN = (h16*)(ws + WS_WIN); h16* WOUT = (h16*)(ws + WS_WOUT); h16* W1 = (h16*)(ws + WS_W1); h16* W2 = (h16*)(ws + WS_W2);
    h16* XN = (h16*)(ws + WS_XN); h16* PROJ = (h16*)(ws + WS_PROJ); h16* MIX = (h16*)(ws + WS_MIX); unsigned short* IDX = (unsigned short*)(ws + WS_IDX);
    float* YTMP = (float*)(ws + WS_YTMP); float* DTV = (float*)(ws + WS_DT); float* MIXO = (float*)(ws + WS_MIXO); h16* HB = (h16*)(ws + WS_H); float* FB = (float*)(ws + WS_F);
    h16* XC = (h16*)(dob + DO_XC); float* SLAB = (float*)dob;

    if (g_grid == 0) {
        int dev = 0, cus = 0;
        if (hipGetDevice(&dev) != hipSuccess || hipDeviceGetAttribute(&cus, hipDeviceAttributeMultiprocessorCount, dev) != hipSuccess) { fprintf(stderr, "kernel_launch: device query failed\n"); g_grid = -1; return; }
        if (hipFuncSetAttribute((const void*)mk_fwd, hipFuncAttributeMaxDynamicSharedMemorySize, LDS_BYTES) != hipSuccess) { fprintf(stderr, "kernel_launch: hipFuncSetAttribute failed\n"); g_grid = -1; return; }
        g_grid = cus;
        if (ws_size < 256 * MiB) fprintf(stderr, "kernel_launch: workspace too small: %zu\n", ws_size);
    }
    if (g_grid < 0) return;
    (void)hipMemsetAsync(ws + WS_CTL, 0, CTL_ZERO_BYTES, stream);
    Args a{};
    for (int i = 0; i < 20; ++i) a.in[i] = (const float*)d_in[i];
    a.out = out; a.ws = ws;
    int li = 0;
    mk_launch(a, 0, 3, li++, stream);
    mk_launch(a, 3, 7, li++, stream);
    for (int q0 = 0; q0 < M; q0 += 1024) {
        nv::scores<<<dim3(T / 256, 1024), 256, 0, stream>>>(PROJ, PF32, q0, SLAB);
        nv::select<<<1024, 256, 0, stream>>>(SLAB, q0, IDX);
    }
    nv::attn<<<M * 8 / 256, 256, 0, stream>>>(PROJ, IDX, rel_bias, YTMP);
    nv::norm512<<<M / 4, 256, 0, stream>>>(YTMP, PROJ, 0, attn_norm, MIX, 512);
    mk_launch(a, 9, 14, li++, stream);
}
```

```cpp
#include <hip/hip_runtime.h>
#include <cstdio>
#include <cstdint>

typedef _Float16 h16;
typedef _Float16 h16x4 __attribute__((ext_vector_type(4)));
typedef _Float16 h16x8 __attribute__((ext_vector_type(8)));
typedef float f32x4 __attribute__((ext_vector_type(4)));

constexpr int NB = 2, T = 8192, D = 1024, M = NB * T, FF = 4096;
constexpr int NPROJ = 3072;
constexpr int C_Z = 0, C_XBC = 512, C_Q = 1536, C_K = 2048, C_V = 2176, C_QI = 2304, C_KI = 2816, C_DT = 2880, C_WI = 2888, C_END = 2896;
constexpr float EPS = 1e-6f;
constexpr int TOPK = 256;

constexpr size_t MiB = 1u << 20;
constexpr size_t WS_CTL = 0, WS_MOD = 1 * MiB, WS_PF32 = 2 * MiB;
constexpr size_t WS_WIN = 4 * MiB, WS_WOUT = 10 * MiB, WS_W1 = 12 * MiB, WS_W2 = 20 * MiB;
constexpr size_t WS_XN = 28 * MiB, WS_PROJ = 60 * MiB;
constexpr size_t WS_STATES = 156 * MiB, WS_PREV = 172 * MiB, WS_DT = 180 * MiB, WS_ACS = WS_DT + 512 * 1024;
constexpr size_t WS_MIX = 181 * MiB, WS_IDX = 213 * MiB, WS_YTMP = 221 * MiB;
constexpr size_t WS_MIXO = 60 * MiB, WS_H = 60 * MiB, WS_F = 188 * MiB;
constexpr size_t DO_XC = 0, DO_XST = 32 * MiB, DO_BT = 48 * MiB;

__device__ __forceinline__ float silu_f(float x) { return x / (1.f + __expf(-x)); }
__device__ __forceinline__ float softplus_f(float x) { return fmaxf(x, 0.f) + log1pf(__expf(-fabsf(x))); }
__device__ __forceinline__ float wave_sum(float v) {
#pragma unroll
    for (int o = 1; o < 64; o <<= 1) v += __shfl_xor(v, o);
    return v;
}
__device__ __forceinline__ int win_src(int n) {
    if (n < C_Q) return n;
    if (n < C_DT) return n + 8;
    if (n < C_WI) return n - C_DT + 1536;
    if (n < C_END) return n;
    return -1;
}
__device__ __forceinline__ int t5_bucket(int n) {
    if (n < 16) return n;
    int b = 16;
    b += (n >= 19); b += (n >= 21); b += (n >= 24); b += (n >= 27); b += (n >= 31); b += (n >= 35); b += (n >= 40); b += (n >= 46);
    b += (n >= 52); b += (n >= 59); b += (n >= 67); b += (n >= 77); b += (n >= 87); b += (n >= 99); b += (n >= 113);
    return b;
}
__device__ __forceinline__ unsigned fkey(float f) { unsigned u = __float_as_uint(f); return (u & 0x80000000u) ? ~u : (u | 0x80000000u); }

namespace nv {
__global__ void prep_w(const float* W, int K, int N, h16* WT, int NT, int mode) {
    const size_t i = (size_t)blockIdx.x * blockDim.x + threadIdx.x; if (i >= (size_t)NT * K) return;
    const int n = (int)(i / K), k = (int)(i % K); const int s = mode ? win_src(n) : n;
    WT[i] = (h16)(s < 0 ? 0.f : W[(size_t)k * N + s]);
}
__global__ void modk(const float* c, const float* w_ada, const float* b_ada, float* mod) {
    const int j = blockIdx.x * blockDim.x + threadIdx.x; if (j >= NB * 6 * D) return;
    const int b = j / (6 * D), jj = j % (6 * D); float acc = b_ada[jj];
    for (int k = 0; k < D; ++k) acc += silu_f(c[b * D + k]) * w_ada[(size_t)k * 6 * D + jj];
    mod[j] = acc;
}
__global__ void norm_mod(const float* x, const float* g, const float* mod, int ci, h16* xn) {
    const int m = blockIdx.x * (blockDim.x / 64) + (threadIdx.x >> 6), lane = threadIdx.x & 63; if (m >= M) return;
    const int b = m / T; const float* xr = x + (size_t)m * D; float v[16]; float ss = 0.f;
#pragma unroll
    for (int j = 0; j < 16; ++j) { v[j] = xr[lane + 64 * j]; ss += v[j] * v[j]; }
    const float rstd = rsqrtf(wave_sum(ss) * (1.f / D) + EPS);
    const float* sh = mod + (size_t)b * 6 * D + ci * D; const float* sc = sh + D;
#pragma unroll
    for (int j = 0; j < 16; ++j) { const int k = lane + 64 * j; xn[(size_t)m * D + k] = (h16)(v[j] * rstd * g[k] * (1.f + sc[k]) + sh[k]); }
}
struct EpiProj { h16* proj; float* pf32;
    __device__ void operator()(int m, int n, float v) const { proj[(size_t)m * NPROJ + n] = (h16)v; if (n >= C_DT && n < C_END) pf32[(size_t)m * 16 + (n - C_DT)] = v; } };
struct EpiF32 { float* C; int ldc; __device__ void operator()(int m, int n, float v) const { C[(size_t)m * ldc + n] = v; } };
struct EpiRelu2 { h16* C; int ldc; __device__ void operator()(int m, int n, float v) const { const float r = fmaxf(v, 0.f); C[(size_t)m * ldc + n] = (h16)(r * r); } };
template <class Epi> __global__ void __launch_bounds__(256) gemm(const h16* A, const h16* Bt, int Mm, int N, int K, Epi epi) {
    __shared__ float As[16][65], Bs[16][65];
    const int tid = threadIdx.x, tx = tid & 15, ty = tid >> 4, m0 = blockIdx.y * 64, n0 = blockIdx.x * 64;
    float acc[4][4] = {};
    const int lr = tid >> 2, lk = (tid & 3) * 4;
    for (int k0 = 0; k0 < K; k0 += 16) {
        const h16x4 a = *(const h16x4*)(A + (size_t)(m0 + lr) * K + k0 + lk), b = *(const h16x4*)(Bt + (size_t)(n0 + lr) * K + k0 + lk);
#pragma unroll
        for (int j = 0; j < 4; ++j) { As[lk + j][lr] = (float)a[j]; Bs[lk + j][lr] = (float)b[j]; }
        __syncthreads();
#pragma unroll
        for (int k = 0; k < 16; ++k) { float av[4], bv[4];
#pragma unroll
            for (int i = 0; i < 4; ++i) { av[i] = As[k][ty * 4 + i]; bv[i] = Bs[k][tx * 4 + i]; }
#pragma unroll
            for (int i = 0; i < 4; ++i)
#pragma unroll
                for (int j = 0; j < 4; ++j) acc[i][j] += av[i] * bv[j]; }
        __syncthreads();
    }
#pragma unroll
    for (int i = 0; i < 4; ++i)
#pragma unroll
        for (int j = 0; j < 4; ++j) epi(m0 + ty * 4 + i, n0 + tx * 4 + j, acc[i][j]);
}
__global__ void conv(const h16* proj, const float* pf32, const float* cw, const float* cb, const float* dt_bias, h16* xc, float* dtv) {
    const size_t i = (size_t)blockIdx.x * blockDim.x + threadIdx.x; if (i >= (size_t)M * 1024) return;
    const int m = (int)(i >> 10), ch = (int)(i & 1023), t = m % T; float acc = cb[ch];
#pragma unroll
    for (int w = 0; w < 4; ++w) { const int tt = t - 3 + w; if (tt >= 0) acc += cw[w * 1024 + ch] * (float)proj[(size_t)(m - 3 + w) * NPROJ + C_XBC + ch]; }
    xc[i] = (h16)silu_f(acc);
    if (ch < 8) dtv[(size_t)m * 8 + ch] = softplus_f(pf32[(size_t)m * 16 + ch] + dt_bias[ch]);
}
__global__ void __launch_bounds__(64) ssd_rec(const h16* xc, const float* dtv, const float* a_log, const float* d_skip, float* y) {
    const int b = blockIdx.x / 8, h = blockIdx.x % 8, g = h / 4, p = threadIdx.x;
    const float a = -__expf(a_log[h]), dsk = d_skip[h]; float st[128];
#pragma unroll
    for (int n = 0; n < 128; ++n) st[n] = 0.f;
    for (int t = 0; t < T; ++t) {
        const size_t m = (size_t)b * T + t; const float dt = dtv[m * 8 + h], dA = __expf(a * dt), xs = (float)xc[m * 1024 + h * 64 + p], xdt = xs * dt;
        const h16* Bp = xc + m * 1024 + 512 + g * 128; const h16* Cp = xc + m * 1024 + 768 + g * 128; float acc = 0.f;
#pragma unroll
        for (int n = 0; n < 128; ++n) { st[n] = st[n] * dA + (float)Bp[n] * xdt; acc += (float)Cp[n] * st[n]; }
        y[m * 512 + h * 64 + p] = acc + dsk * xs;
    }
}
__global__ void norm512(const float* y, const h16* proj, int gate, const float* w, h16* mix, int coff) {
    const int m = blockIdx.x * (blockDim.x / 64) + (threadIdx.x >> 6), lane = threadIdx.x & 63; if (m >= M) return;
    float v[8]; float ss = 0.f;
#pragma unroll
    for (int j = 0; j < 8; ++j) { const int k = lane + 64 * j; float u = y[(size_t)m * 512 + k]; if (gate) u *= silu_f((float)proj[(size_t)m * NPROJ + C_Z + k]); v[j] = u; ss += u * u; }
    const float rstd = rsqrtf(wave_sum(ss) * (1.f / 512.f) + EPS);
#pragma unroll
    for (int j = 0; j < 8; ++j) { const int k = lane + 64 * j; mix[(size_t)m * D + coff + k] = (h16)(v[j] * rstd * w[k]); }
}
__global__ void __launch_bounds__(256) scores(const h16* proj, const float* pf32, int q0, float* slab) {
    __shared__ float qs[512]; __shared__ float ws[8];
    const int ql = blockIdx.y, m = q0 + ql, t = m % T, b = m / T, s = blockIdx.x * 256 + threadIdx.x;
    if (blockIdx.x * 256 > t) return;
    for (int i = threadIdx.x; i < 512; i += 256) qs[i] = (float)proj[(size_t)m * NPROJ + C_QI + i];
    if (threadIdx.x < 8) ws[threadIdx.x] = pf32[(size_t)m * 16 + 8 + threadIdx.x] * 0.35355339059327373f * 0.125f;
    __syncthreads();
    float kv[64]; const h16* kp = proj + (size_t)(b * T + s) * NPROJ + C_KI;
#pragma unroll
    for (int d = 0; d < 64; ++d) kv[d] = (float)kp[d];
    float sc = 0.f;
    for (int h = 0; h < 8; ++h) { float dot = 0.f;
#pragma unroll
        for (int d = 0; d < 64; ++d) dot += qs[h * 64 + d] * kv[d];
        sc += ws[h] * fmaxf(dot, 0.f); }
    slab[(size_t)ql * T + s] = sc;
}
__global__ void __launch_bounds__(256) select(const float* slab, int q0, unsigned short* idx) {
    __shared__ unsigned red[256]; __shared__ unsigned sh_cnt;
    const int ql = blockIdx.x, m = q0 + ql, t = m % T, n = t + 1, tid = threadIdx.x;
    unsigned short* out = idx + (size_t)m * TOPK;
    if (n <= TOPK) { out[tid] = (unsigned short)(tid < n ? tid : 0); return; }
    unsigned key[32];
#pragma unroll
    for (int j = 0; j < 32; ++j) { const int i = tid * 32 + j; key[j] = i < n ? fkey(slab[(size_t)ql * T + i]) : 0u; }
    unsigned Kt = 0u;
    for (int bit = 31; bit >= 0; --bit) {
        const unsigned cand = Kt | (1u << bit); unsigned c = 0;
#pragma unroll
        for (int j = 0; j < 32; ++j) c += (key[j] >= cand);
        if (tid == 0) sh_cnt = 0u; __syncthreads();
        atomicAdd(&sh_cnt, c); __syncthreads();
        if (sh_cnt >= (unsigned)TOPK) Kt = cand;
        __syncthreads();
    }
    unsigned cg = 0, ce = 0;
#pragma unroll
    for (int j = 0; j < 32; ++j) { cg += (key[j] > Kt); ce += (key[j] == Kt); }
    red[tid] = (cg << 16) | ce; __syncthreads();
    unsigned pg = 0, pe = 0, tg = 0;
    for (int i = 0; i < 256; ++i) { const unsigned r = red[i]; if (i < tid) { pg += r >> 16; pe += r & 0xffffu; } tg += r >> 16; }
    const unsigned need = (unsigned)TOPK - tg;
    unsigned sel_before = pg + (pe < need ? pe : need);
#pragma unroll
    for (int j = 0; j < 32; ++j) {
        bool s = false;
        if (key[j] > Kt) s = true; else if (key[j] == Kt) { s = pe < need; ++pe; }
        if (s) { out[sel_before] = (unsigned short)(tid * 32 + j); ++sel_before; }
    }
}
__global__ void __launch_bounds__(256) attn(const h16* proj, const unsigned short* idx, const float* rel_bias, float* y) {
    const int gid = blockIdx.x * 256 + threadIdx.x, m = gid >> 3, h = gid & 7, g = h >> 2, t = m % T, b = m / T;
    const int cnt = (t + 1 < TOPK) ? t + 1 : TOPK;
    float q[64], acc[64];
#pragma unroll
    for (int d = 0; d < 64; ++d) { q[d] = (float)proj[(size_t)m * NPROJ + C_Q + h * 64 + d] * 0.125f; acc[d] = 0.f; }
    float mx = -INFINITY, l = 0.f;
    for (int j = 0; j < cnt; ++j) {
        const int s = idx[(size_t)m * TOPK + j]; const h16* kp = proj + (size_t)(b * T + s) * NPROJ + C_K + g * 64; const h16* vp = kp + (C_V - C_K);
        float lg = rel_bias[t5_bucket(t - s) * 8 + h];
#pragma unroll
        for (int d = 0; d < 64; ++d) lg += q[d] * (float)kp[d];
        const float mn = fmaxf(mx, lg), sc = __expf(mx - mn), pe = __expf(lg - mn);
        l = l * sc + pe; mx = mn;
#pragma unroll
        for (int d = 0; d < 64; ++d) acc[d] = acc[d] * sc + pe * (float)vp[d];
    }
    const float inv = 1.f / l;
#pragma unroll
    for (int d = 0; d < 64; ++d) y[(size_t)m * 512 + h * 64 + d] = acc[d] * inv;
}
__global__ void post1(const float* x, const float* mixo, const float* mod, const float* w1post, const float* w2pre, float* out, h16* xn) {
    const int m = blockIdx.x * (blockDim.x / 64) + (threadIdx.x >> 6), lane = threadIdx.x & 63; if (m >= M) return;
    const int b = m / T; const float* md = mod + (size_t)b * 6 * D; float v[16]; float ss = 0.f;
#pragma unroll
    for (int j = 0; j < 16; ++j) { v[j] = mixo[(size_t)m * D + lane + 64 * j]; ss += v[j] * v[j]; }
    float rstd = rsqrtf(wave_sum(ss) * (1.f / D) + EPS); ss = 0.f;
#pragma unroll
    for (int j = 0; j < 16; ++j) { const int k = lane + 64 * j; v[j] = x[(size_t)m * D + k] + md[2 * D + k] * (v[j] * rstd * w1post[k]); out[(size_t)m * D + k] = v[j]; ss += v[j] * v[j]; }
    rstd = rsqrtf(wave_sum(ss) * (1.f / D) + EPS);
#pragma unroll
    for (int j = 0; j < 16; ++j) { const int k = lane + 64 * j; xn[(size_t)m * D + k] = (h16)(v[j] * rstd * w2pre[k] * (1.f + md[4 * D + k]) + md[3 * D + k]); }
}
__global__ void post2(const float* f, const float* mod, const float* w2post, float* out) {
    const int m = blockIdx.x * (blockDim.x / 64) + (threadIdx.x >> 6), lane = threadIdx.x & 63; if (m >= M) return;
    const int b = m / T; const float* md = mod + (size_t)b * 6 * D; float v[16]; float ss = 0.f;
#pragma unroll
    for (int j = 0; j < 16; ++j) { v[j] = f[(size_t)m * D + lane + 64 * j]; ss += v[j] * v[j]; }
    const float rstd = rsqrtf(wave_sum(ss) * (1.f / D) + EPS);
#pragma unroll
    for (int j = 0; j < 16; ++j) { const int k = lane + 64 * j; out[(size_t)m * D + k] += md[5 * D + k] * (v[j] * rstd * w2post[k]); }
}
}


#define LAS __attribute__((address_space(3)))
#define GAS __attribute__((address_space(1)))
typedef unsigned u32x4 __attribute__((ext_vector_type(4)));
typedef unsigned u32x2 __attribute__((ext_vector_type(2)));
typedef float f32x2 __attribute__((ext_vector_type(2)));
typedef _Float16 h16x2 __attribute__((ext_vector_type(2)));
typedef float f32x16 __attribute__((ext_vector_type(16)));
__device__ __forceinline__ unsigned pk_h2(float lo, float hi) { const f32x2 v = {lo, hi}; const h16x2 h = __builtin_convertvector(v, h16x2); return __builtin_bit_cast(unsigned, h); }

namespace pg8 {
constexpr int BM = 256, BK = 64, HALF = 128, HTB = HALF * BK * 2, STAGE_BYTES = 8 * HTB, NXCD = 8, WGM = 8;
__host__ __device__ __forceinline__ int lds_byte(int r, int c) { const int st = (r >> 4) * 2 + (c >> 5), rr = r & 15, cc = c & 31, ob = rr * 64 + cc * 2; return st * 1024 + (ob ^ (((ob >> 9) & 1) << 5)); }
__host__ __device__ __forceinline__ void stage_rc(int b, int& R, int& C) { const int st = b / 1024, sb = b % 1024, swz = sb ^ (((sb >> 9) & 1) << 5); R = (st >> 1) * 16 + swz / 64; C = (st & 1) * 32 + (swz % 64) / 2; }
__host__ __device__ __forceinline__ int perm32(int rho) { const int n = rho >> 4, i = rho & 15; return 8 * (i >> 2) + 4 * n + (i & 3); }
struct Unit { int pm, pn; };
struct Gemm { const h16* A; const h16* Bt; int M, N, K; };
struct StaticOrder {
    int nM, nN, nwg, G, c;
    __host__ __device__ void init(int M_, int N_, int G_, int c_) { nM = M_ / BM; nN = N_ / BM; nwg = nM * nN; G = G_; c = c_; }
    __host__ __device__ bool next(int i, Unit& u) const {
        const long L = (long)i * G + c; if (L >= nwg) return false;
        int wgid = (int)L; { const int q = nwg / NXCD, r = nwg % NXCD, xcd = wgid % NXCD, off = wgid / NXCD; wgid = (xcd < r ? xcd * (q + 1) : r * (q + 1) + (xcd - r) * q) + off; }
        const int nig = WGM * nN, gid = wgid / nig, fm = gid * WGM, gsz = (nM - fm) < WGM ? (nM - fm) : WGM;
        u.pm = fm + ((wgid % nig) % gsz); u.pn = (wgid % nig) / gsz; return true;
    }
    __device__ __forceinline__ void a_ready(const Unit&) const {}
    __device__ __forceinline__ void done(const Unit&) const {}
};
struct EpiF32 {
    static constexpr bool PERM = false, AFTER_DRAIN = false;
    float* C; int ldc;
    __device__ __forceinline__ void operator()(const f32x4 (&acc)[2][2][4][2], const Unit& u, int wr, int wc, int fr, int fq) const {
        const int row0 = u.pm * BM + wr * 64 + fr, col0 = u.pn * BM + wc * 32 + 4 * fq;
#pragma unroll
        for (int ai = 0; ai < 2; ++ai)
#pragma unroll
            for (int m = 0; m < 4; ++m) { float* rowp = C + (size_t)(row0 + ai * HALF + m * 16) * ldc + col0;
#pragma unroll
                for (int bj = 0; bj < 2; ++bj)
#pragma unroll
                    for (int n = 0; n < 2; ++n) *(f32x4*)(rowp + bj * HALF + n * 16) = acc[ai][bj][m][n]; }
    }
};
template <int ACT  , bool SIDE  > struct EpiH16 {
    static constexpr bool PERM = true, AFTER_DRAIN = false;
    h16* O; int ldc; float* pf32;
    __device__ __forceinline__ void operator()(const f32x4 (&acc)[2][2][4][2], const Unit& u, int wr, int wc, int fr, int fq) const {
        const int row0 = u.pm * BM + wr * 64 + fr, col0 = u.pn * BM + wc * 32 + 8 * fq;
#pragma unroll
        for (int ai = 0; ai < 2; ++ai)
#pragma unroll
            for (int m = 0; m < 4; ++m) { h16* rowp = O + (size_t)(row0 + ai * HALF + m * 16) * ldc + col0;
#pragma unroll
                for (int bj = 0; bj < 2; ++bj) { f32x4 v0 = acc[ai][bj][m][0], v1 = acc[ai][bj][m][1];
                    if (ACT == 1) {
#pragma unroll
                        for (int j = 0; j < 4; ++j) { const float a = fmaxf(v0[j], 0.f), b = fmaxf(v1[j], 0.f); v0[j] = a * a; v1[j] = b * b; } }
                    u32x4 w; w.x = pk_h2(v0[0], v0[1]); w.y = pk_h2(v0[2], v0[3]); w.z = pk_h2(v1[0], v1[1]); w.w = pk_h2(v1[2], v1[3]);
                    *(u32x4*)(rowp + bj * HALF) = w;
                    if (SIDE) { if (bj == 0 && u.pn * BM + 64 == C_DT && wc == 2 && fq < 2) {
                        float* sp = pf32 + (size_t)(row0 + ai * HALF + m * 16) * 16 + 8 * fq; *(f32x4*)sp = acc[ai][0][m][0]; *(f32x4*)(sp + 4) = acc[ai][0][m][1]; } }
                } }
    }
};
template <class Epi, class Sched, bool ALIGN_EPI = false, bool SP2 = false>
__device__ __forceinline__ void gemm_phase(LAS unsigned char* lds, const Gemm g, const Sched& S, const Epi& E) {
    const int tid = threadIdx.x, wid = __builtin_amdgcn_readfirstlane(tid >> 6), lane = tid & 63, wr = wid >> 2, wc = wid & 3, fr = lane & 15, fq = lane >> 4;
    const int K = g.K, nt = K / BK;
    unsigned voffA[2], voffB[2];
#pragma unroll
    for (int i = 0; i < 2; ++i) { int R, C; stage_rc(tid * 16 + i * 8192, R, C); const int Rb = Epi::PERM ? ((R & ~31) + perm32(R & 31)) : R;
        voffA[i] = (unsigned)(R * K + C) * 2u; voffB[i] = (unsigned)(Rb * K + C) * 2u; }
    const size_t kstep = (size_t)(BK * 2);
    const size_t hstep = (size_t)HALF * K * 2;
    const size_t tstep = 2 * hstep;
    const unsigned ldsw = (unsigned)wid * 1024u;
    const int aoff = lds_byte(wr * 64 + fr, fq * 8), boff = lds_byte(wc * 32 + fr, fq * 8);
#define PG8_SA(b, h) (((b) * 2 + (h)) * HTB)
#define PG8_SB(b, h) ((4 + (b) * 2 + (h)) * HTB)
#define PG8_STAGE(bufoff, gbase, voff) do { _Pragma("unroll") for (int _i = 0; _i < 2; ++_i) \
        __builtin_amdgcn_global_load_lds((const unsigned*)((const char*)(gbase) + (voff)[_i]), (LAS unsigned*)(lds + (bufoff) + ldsw + _i * 8192), 16, 0, 0); } while (0)
#define PG8_LDA(dst, b, h) do { _Pragma("unroll") for (int m = 0; m < 4; ++m) _Pragma("unroll") for (int k = 0; k < 2; ++k) dst[m][k] = *(const LAS h16x8*)(lds + PG8_SA(b, h) + aoff + m * 2048 + k * 1024); } while (0)
#define PG8_LDB(dst, b, h) do { _Pragma("unroll") for (int n = 0; n < 2; ++n) _Pragma("unroll") for (int k = 0; k < 2; ++k) dst[n][k] = *(const LAS h16x8*)(lds + PG8_SB(b, h) + boff + n * 2048 + k * 1024); } while (0)
#define PG8_MMA(ai, bj, At, Bt) do { __builtin_amdgcn_s_setprio(1); _Pragma("unroll") for (int m = 0; m < 4; ++m) _Pragma("unroll") for (int n = 0; n < 2; ++n) _Pragma("unroll") for (int k = 0; k < 2; ++k) \
        acc[ai][bj][m][n] = __builtin_amdgcn_mfma_f32_16x16x32_f16(Bt[n][k], At[m][k], acc[ai][bj][m][n], 0, 0, 0); __builtin_amdgcn_s_setprio(0); } while (0)
#define PG8_WAIT_V(n) asm volatile("s_waitcnt vmcnt(" #n ")" ::: "memory")
#define PG8_WAIT_L(n) asm volatile("s_waitcnt lgkmcnt(" #n ")" ::: "memory")
#define PG8_BAR __builtin_amdgcn_s_barrier()
#define PG8_SCHED __builtin_amdgcn_sched_barrier(0)
    Unit cur, nxt; int ui = 0;
    if (!S.next(0, cur)) return;
    f32x4 acc[2][2][4][2];
#pragma unroll
    for (int a = 0; a < 2; ++a)
#pragma unroll
        for (int b = 0; b < 2; ++b)
#pragma unroll
            for (int m = 0; m < 4; ++m)
#pragma unroll
                for (int n = 0; n < 2; ++n) acc[a][b][m][n] = (f32x4){0.f, 0.f, 0.f, 0.f};
    h16x8 At[4][2], B0[2][2], B1[2][2];
    const char* cA = (const char*)g.A + (size_t)cur.pm * tstep; const char* cB = (const char*)g.Bt + (size_t)cur.pn * tstep;
    S.a_ready(cur);
    if constexpr (SP2) {
        PG8_STAGE(PG8_SB(0, 0), cB, voffB); PG8_STAGE(PG8_SB(0, 1), cB + hstep, voffB); PG8_STAGE(PG8_SA(0, 0), cA, voffA); PG8_STAGE(PG8_SA(0, 1), cA + hstep, voffA);
        if (wr == 1) PG8_BAR;
        PG8_WAIT_V(2); PG8_BAR;
        PG8_STAGE(PG8_SB(1, 0), cB + kstep, voffB); PG8_STAGE(PG8_SA(1, 0), cA + kstep, voffA); PG8_STAGE(PG8_SB(1, 1), cB + hstep + kstep, voffB);
        PG8_WAIT_V(6); PG8_BAR;
    } else {
        PG8_STAGE(PG8_SB(0, 0), cB, voffB); PG8_STAGE(PG8_SA(0, 0), cA, voffA); PG8_STAGE(PG8_SB(0, 1), cB + hstep, voffB); PG8_STAGE(PG8_SA(0, 1), cA + hstep, voffA);
        if (wr == 1) PG8_BAR;
        PG8_WAIT_V(4); PG8_BAR;
        PG8_STAGE(PG8_SB(1, 0), cB + kstep, voffB); PG8_STAGE(PG8_SA(1, 0), cA + kstep, voffA); PG8_STAGE(PG8_SB(1, 1), cB + hstep + kstep, voffB);
        PG8_WAIT_V(6); PG8_BAR;
    }
    for (;;) {
        const bool has_next = S.next(ui + 1, nxt);
        const char* nA = has_next ? (const char*)g.A + (size_t)nxt.pm * tstep : cA; const char* nB = has_next ? (const char*)g.Bt + (size_t)nxt.pn * tstep : cB;
        for (int t = 0; t < nt; t += 2) {
            const bool last = (t == nt - 2);
            const char* a1 = cA + (size_t)(t + 1) * kstep;
            const char* a2 = last ? nA : cA + (size_t)(t + 2) * kstep; const char* b2 = last ? nB : cB + (size_t)(t + 2) * kstep;
            const char* a3 = a2 + kstep; const char* b3 = b2 + kstep;
            if (last && has_next) S.a_ready(nxt);
            if constexpr (SP2) {
            PG8_LDB(B0, 0, 0); PG8_LDB(B1, 0, 1); PG8_SCHED; PG8_LDA(At, 0, 0); PG8_STAGE(PG8_SA(1, 1), a1 + hstep, voffA);
            PG8_WAIT_V(8); PG8_WAIT_L(0); PG8_BAR; PG8_MMA(0, 0, At, B0); PG8_MMA(0, 1, At, B1); PG8_BAR; PG8_SCHED;
            PG8_LDA(At, 0, 1); PG8_STAGE(PG8_SB(0, 0), b2, voffB); PG8_STAGE(PG8_SB(0, 1), b2 + hstep, voffB); PG8_STAGE(PG8_SA(0, 0), a2, voffA);
            PG8_WAIT_V(8); PG8_WAIT_L(0); PG8_BAR; PG8_MMA(1, 0, At, B0); PG8_MMA(1, 1, At, B1); PG8_BAR; PG8_SCHED;
            PG8_LDB(B0, 1, 0); PG8_LDB(B1, 1, 1); PG8_SCHED; PG8_LDA(At, 1, 0); PG8_STAGE(PG8_SA(0, 1), a2 + hstep, voffA);
            PG8_WAIT_V(8); PG8_WAIT_L(0); PG8_BAR; PG8_MMA(0, 0, At, B0); PG8_MMA(0, 1, At, B1); PG8_BAR; PG8_SCHED;
            PG8_LDA(At, 1, 1); PG8_STAGE(PG8_SB(1, 0), b3, voffB); PG8_STAGE(PG8_SB(1, 1), b3 + hstep, voffB); PG8_STAGE(PG8_SA(1, 0), a3, voffA);
            PG8_WAIT_V(8); PG8_WAIT_L(0); PG8_BAR; PG8_MMA(1, 0, At, B0); PG8_MMA(1, 1, At, B1); PG8_BAR; PG8_SCHED;
            } else {
            PG8_LDB(B0, 0, 0); PG8_SCHED; PG8_LDA(At, 0, 0); PG8_STAGE(PG8_SA(1, 1), a1 + hstep, voffA);
            PG8_WAIT_L(8); PG8_BAR; PG8_WAIT_L(0); PG8_MMA(0, 0, At, B0); PG8_BAR; PG8_SCHED;
            PG8_LDB(B1, 0, 1); PG8_STAGE(PG8_SB(0, 0), b2, voffB);
            PG8_BAR; PG8_WAIT_L(0); PG8_MMA(0, 1, At, B1); PG8_BAR;
            PG8_LDA(At, 0, 1); PG8_STAGE(PG8_SA(0, 0), a2, voffA);
            PG8_BAR; PG8_WAIT_L(0); PG8_MMA(1, 0, At, B0); PG8_BAR; PG8_SCHED;
            PG8_STAGE(PG8_SB(0, 1), b2 + hstep, voffB);
            PG8_WAIT_V(6); PG8_BAR; PG8_MMA(1, 1, At, B1); PG8_BAR;
            PG8_LDB(B0, 1, 0); PG8_SCHED; PG8_LDA(At, 1, 0); PG8_STAGE(PG8_SA(0, 1), a2 + hstep, voffA);
            PG8_WAIT_L(8); PG8_BAR; PG8_WAIT_L(0); PG8_MMA(0, 0, At, B0); PG8_BAR; PG8_SCHED;
            PG8_LDB(B1, 1, 1); PG8_STAGE(PG8_SB(1, 0), b3, voffB);
            PG8_BAR; PG8_WAIT_L(0); PG8_MMA(0, 1, At, B1); PG8_BAR;
            PG8_LDA(At, 1, 1); PG8_STAGE(PG8_SA(1, 0), a3, voffA);
            PG8_BAR; PG8_WAIT_L(0); PG8_MMA(1, 0, At, B0); PG8_BAR; PG8_SCHED;
            PG8_STAGE(PG8_SB(1, 1), b3 + hstep, voffB);
            PG8_WAIT_V(6); PG8_BAR; PG8_MMA(1, 1, At, B1); PG8_BAR;
            }
        }
        if constexpr (ALIGN_EPI) { if (wr == 0) PG8_BAR; }
        if constexpr (!Epi::AFTER_DRAIN) { E(acc, cur, wr, wc, fr, fq); S.done(cur); }
        if (!has_next) break;
#pragma unroll
        for (int a = 0; a < 2; ++a)
#pragma unroll
            for (int b = 0; b < 2; ++b)
#pragma unroll
                for (int m = 0; m < 4; ++m)
#pragma unroll
                    for (int n = 0; n < 2; ++n) acc[a][b][m][n] = (f32x4){0.f, 0.f, 0.f, 0.f};
        cur = nxt; cA = nA; cB = nB; ++ui;
        if constexpr (ALIGN_EPI) { if (wr == 1) PG8_BAR; }
    }
    PG8_WAIT_V(0);
    if constexpr (!ALIGN_EPI) { if (wr == 0) PG8_BAR; }
    PG8_BAR;
    if constexpr (Epi::AFTER_DRAIN) { E.fused(acc, cur, wr, wc, fr, fq, lds, wid, lane); S.done(cur); }
#undef PG8_SA
#undef PG8_SB
#undef PG8_STAGE
#undef PG8_LDA
#undef PG8_LDB
#undef PG8_MMA
#undef PG8_WAIT_V
#undef PG8_WAIT_L
#undef PG8_BAR
#undef PG8_SCHED
}
}

#define XB_TMO      128
#define XB_XCNT(j)  (256  + 64 * (j))
#define XB_XSUB(j)  (1280 + 64 * (j))
#define XB_XGEN(j)  (2304 + 64 * (j))
#define XB_TOP      3328
#define XB_TOPGEN   3392
#define XCD_BAR_WORDS 3456
#define XB_SPIN_CAP (1u << 22)
__device__ __forceinline__ unsigned xb_ld(unsigned* p)              { return __hip_atomic_load(p, __ATOMIC_RELAXED, __HIP_MEMORY_SCOPE_AGENT); }
__device__ __forceinline__ unsigned xb_add(unsigned* p, unsigned v) { return __hip_atomic_fetch_add(p, v, __ATOMIC_RELAXED, __HIP_MEMORY_SCOPE_AGENT); }
__device__ __forceinline__ unsigned xb_xcc_id() { return (unsigned)__builtin_amdgcn_s_getreg((3 << 11) | 20) & 0xFu; }
#define XB_SPIN(cond, bar) do { unsigned _sp = 0; while (cond) { __builtin_amdgcn_s_sleep(1); \
    if ((++_sp & 255u) == 0u) { if (xb_ld(&(bar)[XB_TMO])) break; if (_sp > XB_SPIN_CAP) { atomicAdd(&(bar)[XB_TMO], 1u); break; } } } } while (0)
struct XcdBarrier { unsigned* bar; unsigned x; volatile LAS unsigned* st; };
__device__ __forceinline__ XcdBarrier xcd_barrier_post(unsigned* bar, volatile LAS unsigned* st) {
    XcdBarrier b; b.bar = bar; b.x = xb_xcc_id(); b.st = st;
    if (threadIdx.x == 0) (void)xb_add(&bar[XB_XCNT(b.x)], 1u);
    return b;
}
__device__ __forceinline__ void xcd_barrier_complete(unsigned* bar, unsigned x, unsigned& nloc, unsigned& nx) {
    const unsigned G = gridDim.x * gridDim.y * gridDim.z;
    unsigned sum, cnt, mine, sp = 0u;
    for (;;) {
        sum = 0u; cnt = 0u; mine = 0u;
#pragma unroll
        for (unsigned j = 0; j < 16; ++j) { const unsigned c = xb_ld(&bar[XB_XCNT(j)]); sum += c; cnt += (c > 0u) ? 1u : 0u; mine = (j == x) ? c : mine; }
        if (sum == G) break;
        __builtin_amdgcn_s_sleep(1);
        if ((++sp & 255u) == 0u) { if (xb_ld(&bar[XB_TMO])) break; if (sp > XB_SPIN_CAP) { atomicAdd(&bar[XB_TMO], 1u); break; } }
    }
    nloc = mine > 0u ? mine : 1u; nx = cnt > 0u ? cnt : 1u;
}
__device__ __forceinline__ void xcd_barrier(const XcdBarrier& b) {
    asm volatile("s_waitcnt vmcnt(0)" ::: "memory");
    __syncthreads();
    if (threadIdx.x == 0) {
        unsigned* bar = b.bar;
        __builtin_amdgcn_s_waitcnt(0);
        unsigned nloc = b.st[0], nx = b.st[1];
        if (nloc == 0u) { xcd_barrier_complete(bar, b.x, nloc, nx); b.st[0] = nloc; b.st[1] = nx; }
        const unsigned old = xb_add(&bar[XB_XSUB(b.x)], 1u);
        const unsigned gen = old / nloc;
        if (old + 1u == (gen + 1u) * nloc) {
            __builtin_amdgcn_fence(__ATOMIC_RELEASE, "agent");
            asm volatile("s_waitcnt vmcnt(0)" ::: "memory");
            const unsigned og = xb_add(&bar[XB_TOP], 1u);
            const unsigned tg = og / nx;
            if (og + 1u == (tg + 1u) * nx) xb_add(&bar[XB_TOPGEN], 1u);
            else XB_SPIN(xb_ld(&bar[XB_TOPGEN]) == tg, bar);
            __builtin_amdgcn_fence(__ATOMIC_ACQUIRE, "agent");
            xb_add(&bar[XB_XGEN(b.x)], 1u);
            asm volatile("s_waitcnt vmcnt(0)" ::: "memory");
        } else {
            XB_SPIN(xb_ld(&bar[XB_XGEN(b.x)]) == gen, bar);
            __builtin_amdgcn_fence(__ATOMIC_ACQUIRE, "agent");
            asm volatile("s_waitcnt vmcnt(0)" ::: "memory");
        }
    }
    __syncthreads();
}

constexpr int NWAVES = 8, NTHR = NWAVES * 64;
constexpr int RING_BYTES = 131072, MISC_OFF = RING_BYTES, AUX_OFF = MISC_OFF + 256, LDS_BYTES = 147456;
constexpr size_t WS_MODP = WS_MOD + 64 * 1024;
constexpr int CW_BAR = 1024;
constexpr int MAX_LAUNCH = 8;
constexpr size_t CTL_ZERO_BYTES = (size_t)(CW_BAR + MAX_LAUNCH * XCD_BAR_WORDS) * 4;
#define LDS_WAIT() asm volatile("s_waitcnt lgkmcnt(0)" ::: "memory")

struct Args { const float* in[20]; float* out; unsigned char* ws; int ph_lo, ph_hi, li, pad; };
enum { I_X = 0, I_C, I_WADA, I_BADA, I_N1PRE, I_N1POST, I_WIN, I_CONVW, I_CONVB, I_DTB, I_ALOG, I_DSKIP, I_SSMN, I_RELB, I_ATTN, I_WOUT, I_N2PRE, I_N2POST, I_W1, I_W2 };

template <int MODE> __device__ __forceinline__ void p0_transpose_item(const float* W, int K, int N, h16* WT, LAS float* scr, int item, int nblk, int lane) {
    const int kb = item / nblk, nb = item % nblk, k0 = 64 * kb, n0 = 32 * nb;
    const int sc = MODE ? win_src(n0 + (lane & 31)) : n0 + (lane & 31);
#pragma unroll 8
    for (int i = 0; i < 32; ++i) { const int kk = 2 * i + (lane >> 5); scr[kk * 33 + (lane & 31)] = sc >= 0 ? W[(size_t)(k0 + kk) * N + sc] : 0.f; }
    LDS_WAIT(); asm volatile("" ::: "memory");
    const int c = lane & 7;
#pragma unroll
    for (int j = 0; j < 4; ++j) { const int n = (lane >> 3) + 8 * j; const LAS float* s = scr + (8 * c) * 33 + n;
        u32x4 o; o.x = pk_h2(s[0 * 33], s[1 * 33]); o.y = pk_h2(s[2 * 33], s[3 * 33]); o.z = pk_h2(s[4 * 33], s[5 * 33]); o.w = pk_h2(s[6 * 33], s[7 * 33]);
        *(u32x4*)(WT + (size_t)(n0 + n) * K + k0 + 8 * c) = o; }
    LDS_WAIT(); asm volatile("" ::: "memory");
}

__global__ void __launch_bounds__(NTHR, 2) mk_fwd(Args args) {
    extern __shared__ __attribute__((aligned(16))) unsigned char lds_raw[];
    LAS unsigned char* lds = (LAS unsigned char*)lds_raw;
    volatile LAS unsigned* MISC = (volatile LAS unsigned*)(lds + MISC_OFF);
    const int tid = threadIdx.x, lane = tid & 63, wave = __builtin_amdgcn_readfirstlane(tid >> 6);
    const int G = gridDim.x, bx = blockIdx.x, gw = bx * NWAVES + wave, NGW = G * NWAVES;
    unsigned char* ws = args.ws;
    unsigned* ctl = (unsigned*)(ws + WS_CTL);
    const float* x = args.in[I_X]; float* out = args.out;
    float* MOD = (float*)(ws + WS_MOD); float* MODP = (float*)(ws + WS_MODP); float* PF32 = (float*)(ws + WS_PF32);
    h16* WIN = (h16*)(ws + WS_WIN); h16* WOUT = (h16*)(ws + WS_WOUT); h16* W1 = (h16*)(ws + WS_W1); h16* W2 = (h16*)(ws + WS_W2);
    h16* XN = (h16*)(ws + WS_XN); h16* PROJ = (h16*)(ws + WS_PROJ); h16* MIX = (h16*)(ws + WS_MIX);
    float* MIXO = (float*)(ws + WS_MIXO); h16* HB = (h16*)(ws + WS_H); float* FB = (float*)(ws + WS_F);
    if (tid < 64) MISC[tid] = 0u;
    __syncthreads();
    XcdBarrier bar = xcd_barrier_post(ctl + CW_BAR + args.li * XCD_BAR_WORDS, MISC + 8);
    const int lo = args.ph_lo, hi = args.ph_hi;
#define IN(k) (lo <= (k) && (k) < hi)
#define SEAM(k) do { if (IN(k) && IN((k) + 1)) xcd_barrier(bar); } while (0)

    if (IN(0)) {
        LAS float* scr = (LAS float*)(lds + wave * 16384);
        constexpr int I_IN = 16 * 96, I_O = 16 * 32, I_1 = 16 * 128, I_2 = 64 * 32, I_M = 96 * 16, NITEMS = I_IN + I_O + I_1 + I_2 + I_M;
        for (int it = gw; it < NITEMS; it += NGW) {
            int r = it;
            if (r < I_IN) { p0_transpose_item<1>(args.in[I_WIN], D, 2896, WIN, scr, r, 96, lane); continue; } r -= I_IN;
            if (r < I_O) { p0_transpose_item<0>(args.in[I_WOUT], D, D, WOUT, scr, r, 32, lane); continue; } r -= I_O;
            if (r < I_1) { p0_transpose_item<0>(args.in[I_W1], D, FF, W1, scr, r, 128, lane); continue; } r -= I_1;
            if (r < I_2) { p0_transpose_item<0>(args.in[I_W2], FF, D, W2, scr, r, 32, lane); continue; } r -= I_2;
            const int cg = r % 96, ks = r / 96, jj = cg * 64 + lane, k0 = ks * 64;
            const float s0 = silu_f(args.in[I_C][k0 + lane]), s1 = silu_f(args.in[I_C][D + k0 + lane]);
            const float* wp = args.in[I_WADA] + (size_t)k0 * (6 * D) + jj; float a0 = 0.f, a1 = 0.f;
#pragma unroll 16
            for (int kk = 0; kk < 64; ++kk) { const float w = wp[(size_t)kk * (6 * D)]; a0 += __shfl(s0, kk) * w; a1 += __shfl(s1, kk) * w; }
            MODP[(size_t)(ks * 2 + 0) * (6 * D) + jj] = a0; MODP[(size_t)(ks * 2 + 1) * (6 * D) + jj] = a1;
        }
    }
    SEAM(0);
    if (IN(1)) {
        for (int i = bx * NTHR + tid; i < NB * 6 * D; i += G * NTHR) { const int b = i / (6 * D), jj = i % (6 * D); float a = args.in[I_BADA][jj];
#pragma unroll
            for (int ks = 0; ks < 16; ++ks) a += MODP[(size_t)(ks * 2 + b) * (6 * D) + jj];
            MOD[i] = a; }
        LAS float* mv = (LAS float*)lds;
        for (int i = tid; i < NB * 2 * D; i += NTHR) { const int b = i / (2 * D), jj = i % (2 * D); float a = args.in[I_BADA][jj];
#pragma unroll
            for (int ks = 0; ks < 16; ++ks) a += MODP[(size_t)(ks * 2 + b) * (6 * D) + jj];
            mv[i] = a; }
        __syncthreads();
        const float* g1 = args.in[I_N1PRE];
        for (int m = gw; m < M; m += NGW) {
            const int b = m / T; const f32x4* xr = (const f32x4*)(x + (size_t)m * D) + lane; f32x4 v[4]; float ss = 0.f;
#pragma unroll
            for (int j = 0; j < 4; ++j) { v[j] = xr[64 * j]; ss += (v[j].x * v[j].x + v[j].y * v[j].y) + (v[j].z * v[j].z + v[j].w * v[j].w); }
            const float rstd = rsqrtf(wave_sum(ss) * (1.f / D) + EPS);
            u32x2* o8 = (u32x2*)(XN + (size_t)m * D) + lane;
#pragma unroll
            for (int j = 0; j < 4; ++j) { const int k = 4 * lane + 256 * j; const f32x4 gg = *(const f32x4*)(g1 + k);
                const f32x4 sh = *(const LAS f32x4*)(mv + b * 2 * D + k), sc = *(const LAS f32x4*)(mv + b * 2 * D + D + k);
                const f32x4 r = v[j] * rstd * gg * (sc + 1.f) + sh; u32x2 w; w.x = pk_h2(r.x, r.y); w.y = pk_h2(r.z, r.w); o8[64 * j] = w; }
        }
        __syncthreads();
    }
    SEAM(1);
    if (IN(2)) {
        pg8::Gemm g{XN, WIN, M, NPROJ, D}; pg8::StaticOrder S; S.init(M, NPROJ, G, bx);
        pg8::EpiH16<0, true> E{PROJ, NPROJ, PF32};
        pg8::gemm_phase<pg8::EpiH16<0, true>, pg8::StaticOrder, true, true>(lds, g, S, E);
    }
    SEAM(2);
    if (IN(3)) {
        LAS h16* raw = (LAS h16*)(lds + wave * 16384);
        constexpr int N_CONV = NB * 128 * 16, N_SCAN = NB * 32 * 8;
        for (int it = gw; it < N_CONV + N_SCAN; it += NGW) {
            if (it < N_CONV) {
                const int cb = it & 15, tb = (it >> 4) & 127, b = it >> 11, t0 = tb * 64; const size_t m0 = (size_t)b * T + t0;
#pragma unroll
                for (int i = 0; i < 9; ++i) { const int row = (lane >> 3) + 8 * i, ch = lane & 7; u32x4 v = {0u, 0u, 0u, 0u};
                    if (row < 67 && t0 - 3 + row >= 0) v = *(const u32x4*)(PROJ + (m0 - 3 + row) * NPROJ + C_XBC + cb * 64 + ch * 8);
                    *(LAS u32x4*)(raw + row * 64 + ch * 8) = v; }
                LDS_WAIT(); asm volatile("" ::: "memory");
                const int chn = cb * 64 + lane;
                const float w0 = args.in[I_CONVW][chn], w1 = args.in[I_CONVW][1024 + chn], w2 = args.in[I_CONVW][2048 + chn], w3 = args.in[I_CONVW][3072 + chn], cbias = args.in[I_CONVB][chn];
                float r0 = (float)raw[lane], r1 = (float)raw[64 + lane], r2 = (float)raw[128 + lane];
                unsigned yp[32];
#pragma unroll
                for (int t = 0; t < 64; t += 2) {
                    const float r3 = (float)raw[(t + 3) * 64 + lane], r4 = (float)raw[(t + 4) * 64 + lane];
                    const float a0 = cbias + w0 * r0 + w1 * r1 + w2 * r2 + w3 * r3, a1 = cbias + w0 * r1 + w1 * r2 + w2 * r3 + w3 * r4;
                    const float y0 = a0 * __builtin_amdgcn_rcpf(1.f + __expf(-a0)), y1 = a1 * __builtin_amdgcn_rcpf(1.f + __expf(-a1));
                    yp[t >> 1] = pk_h2(y0, y1);
                    raw[t * 64 + lane] = (h16)y0; raw[(t + 1) * 64 + lane] = (h16)y1;
                    r0 = r2; r1 = r3; r2 = r4;
                }
                LDS_WAIT(); asm volatile("" ::: "memory");
                h16* xc = (h16*)((unsigned char*)out + DO_XC);
#pragma unroll
                for (int i = 0; i < 8; ++i) { const int row = (lane >> 3) + 8 * i, ch = lane & 7;
                    *(u32x4*)(xc + (m0 + row) * 1024 + cb * 64 + ch * 8) = *(const LAS u32x4*)(raw + row * 64 + ch * 8); }
                if (cb < 12) {
                    h16* dst = cb < 8 ? (h16*)((unsigned char*)out + DO_XST) + ((size_t)(b * 8 + cb) * 64 + lane) * T + t0
                                      : (h16*)((unsigned char*)out + DO_BT) + ((size_t)(b * 2 + ((cb - 8) >> 1)) * 128 + ((cb - 8) & 1) * 64 + lane) * T + t0;
#pragma unroll
                    for (int i = 0; i < 8; ++i) { u32x4 v = {yp[4 * i], yp[4 * i + 1], yp[4 * i + 2], yp[4 * i + 3]}; *(u32x4*)(dst + 8 * i) = v; }
                }
                LDS_WAIT(); asm volatile("" ::: "memory");
            } else {
                const int r = it - N_CONV, h = r & 7, c = (r >> 3) & 31, b = r >> 8; const size_t m = (size_t)b * T + c * 256 + 4 * lane;
                const float a = -__expf(args.in[I_ALOG][h]), bias = args.in[I_DTB][h];
                f32x4 dt, cs; float run = 0.f;
#pragma unroll
                for (int j = 0; j < 4; ++j) { dt[j] = softplus_f(PF32[(m + j) * 16 + h] + bias); run += a * dt[j]; cs[j] = run; }
                float incl = run;
#pragma unroll
                for (int o = 1; o < 64; o <<= 1) { const float u = __shfl_up(incl, o); if (lane >= o) incl += u; }
                const float excl = incl - run;
                float* DTp = (float*)(ws + WS_DT); float* ACSp = (float*)(ws + WS_ACS); const size_t o4 = (size_t)(b * 8 + h) * T + c * 256 + 4 * lane;
                *(f32x4*)(DTp + o4) = dt; *(f32x4*)(ACSp + o4) = cs + excl;
            }
        }
    }
    SEAM(3);
    if (IN(4)) {
        LAS float* wtab = (LAS float*)lds;
        const h16* XST = (const h16*)((unsigned char*)out + DO_XST); const h16* BT = (const h16*)((unsigned char*)out + DO_BT);
        const float* DTp = (const float*)(ws + WS_DT); const float* ACSp = (const float*)(ws + WS_ACS); float* ST = (float*)(ws + WS_STATES);
        const int r = lane & 31, hh = lane >> 5, pt = wave & 1, ntile = wave >> 1;
        for (int u = bx; u < NB * 32 * 8; u += G) {
            const int h = u & 7, c = (u >> 3) & 31, b = u >> 8, g = h >> 2; const size_t tb = (size_t)(b * 8 + h) * T + c * 256;
            if (tid < 256) wtab[tid] = DTp[tb + tid] * __expf(ACSp[tb + 255] - ACSp[tb + tid]);
            __syncthreads();
            f32x16 acc;
#pragma unroll
            for (int i = 0; i < 16; ++i) acc[i] = 0.f;
            const h16* ap = XST + ((size_t)(b * 8 + h) * 64 + pt * 32 + r) * T + c * 256 + 8 * hh;
            const h16* bp = BT + ((size_t)(b * 2 + g) * 128 + ntile * 32 + r) * T + c * 256 + 8 * hh;
#pragma unroll 4
            for (int ks = 0; ks < 16; ++ks) {
                const h16x8 A = *(const h16x8*)(ap + 16 * ks), Bv = *(const h16x8*)(bp + 16 * ks);
                const f32x4 wa = *(const LAS f32x4*)(wtab + 16 * ks + 8 * hh), wb = *(const LAS f32x4*)(wtab + 16 * ks + 8 * hh + 4);
                h16x8 Bs;
#pragma unroll
                for (int j = 0; j < 4; ++j) { Bs[j] = (h16)((float)Bv[j] * wa[j]); Bs[4 + j] = (h16)((float)Bv[4 + j] * wb[j]); }
                acc = __builtin_amdgcn_mfma_f32_32x32x16_f16(A, Bs, acc, 0, 0, 0);
            }
            float* sp = ST + ((size_t)((b * 32 + c) * 8 + h) * 64 + pt * 32) * 128 + ntile * 32 + r;
#pragma unroll
            for (int i = 0; i < 16; ++i) sp[(size_t)((i & 3) + 8 * (i >> 2) + 4 * hh) * 128] = acc[i];
            __syncthreads();
        }
    }
    SEAM(4);
    if (IN(5)) {
        const float* ACSp = (const float*)(ws + WS_ACS); const float* ST = (const float*)(ws + WS_STATES); h16* PV = (h16*)(ws + WS_PREV);
        for (int e = bx * NTHR + tid; e < NB * 8 * 64 * 128; e += G * NTHR) {
            const int pn = e & 8191, h = (e >> 13) & 7, b = e >> 16; float hs = 0.f;
            float sv[32];
#pragma unroll
            for (int c = 0; c < 32; ++c) sv[c] = ST[(size_t)((b * 32 + c) * 8 + h) * 8192 + pn];
#pragma unroll
            for (int c = 0; c < 32; ++c) { PV[(size_t)((b * 32 + c) * 8 + h) * 8192 + pn] = (h16)hs; hs = hs * __expf(ACSp[(size_t)(b * 8 + h) * T + c * 256 + 255]) + sv[c]; }
        }
    }
    SEAM(5);
    if (IN(6)) {
        LAS float* acs_tab = (LAS float*)lds; LAS float* dt_tab = acs_tab + 2048; LAS float* part = dt_tab + 2048;
        const h16* XC = (const h16*)((unsigned char*)out + DO_XC); const h16* XST = (const h16*)((unsigned char*)out + DO_XST);
        const float* DTp = (const float*)(ws + WS_DT); const float* ACSp = (const float*)(ws + WS_ACS); const h16* PV = (const h16*)(ws + WS_PREV);
        const int r = lane & 31, hh = lane >> 5, h = wave, g = h >> 2; const float dsk = args.in[I_DSKIP][h];
        for (int i = 0;; ++i) {
            const int j = i * G + bx; if (j >= NB * 32 * 8) break;
            const int bc = j >> 3, lbr = j & 7, lb = (i & 1) ? 7 - lbr : lbr, b = bc >> 5, c = bc & 31, t0 = c * 256;
            for (int k = tid; k < 2048; k += NTHR) { const size_t o = (size_t)(b * 8 + (k >> 8)) * T + t0 + (k & 255); acs_tab[k] = ACSp[o]; dt_tab[k] = DTp[o]; }
            __syncthreads();
            const int l = lb * 32 + r; const size_t ml = (size_t)b * T + t0 + l; const float acs_l = acs_tab[h * 256 + l];
            h16x8 Cf[8];
#pragma unroll
            for (int ks = 0; ks < 8; ++ks) Cf[ks] = *(const h16x8*)(XC + ml * 1024 + 768 + g * 128 + 16 * ks + 8 * hh);
            f32x16 Y[2];
#pragma unroll
            for (int q = 0; q < 16; ++q) { Y[0][q] = 0.f; Y[1][q] = 0.f; }
            const h16* xst = XST + ((size_t)(b * 8 + h) * 64 + r) * T + t0 + 4 * hh;
            for (int sb = 0; sb <= lb; ++sb) {
                const size_t ms = (size_t)b * T + t0 + sb * 32 + r;
                f32x16 Dv;
#pragma unroll
                for (int q = 0; q < 16; ++q) Dv[q] = 0.f;
#pragma unroll
                for (int ks = 0; ks < 8; ++ks) { const h16x8 Bf = *(const h16x8*)(XC + ms * 1024 + 512 + g * 128 + 16 * ks + 8 * hh); Dv = __builtin_amdgcn_mfma_f32_32x32x16_f16(Bf, Cf[ks], Dv, 0, 0, 0); }
                h16x8 Mf[2];
#pragma unroll
                for (int q = 0; q < 4; ++q) { const int sl = sb * 32 + 8 * q + 4 * hh;
                    const f32x4 as = *(const LAS f32x4*)(acs_tab + h * 256 + sl), ds = *(const LAS f32x4*)(dt_tab + h * 256 + sl);
#pragma unroll
                    for (int e = 0; e < 4; ++e) { float v = Dv[4 * q + e] * __expf(acs_l - as[e]) * ds[e]; if (sl + e > l) v = 0.f; Mf[q >> 1][(q & 1) * 4 + e] = (h16)v; } }
#pragma unroll
                for (int s2 = 0; s2 < 2; ++s2)
#pragma unroll
                    for (int pt = 0; pt < 2; ++pt) { const h16* ap = xst + (size_t)(pt * 32) * T + sb * 32 + 16 * s2;
                        const h16x4 lo = *(const h16x4*)ap, hi = *(const h16x4*)(ap + 8);
                        const h16x8 A = {lo[0], lo[1], lo[2], lo[3], hi[0], hi[1], hi[2], hi[3]};
                        Y[pt] = __builtin_amdgcn_mfma_f32_32x32x16_f16(A, Mf[s2], Y[pt], 0, 0, 0); }
            }
            {
                f32x16 O[2];
#pragma unroll
                for (int q = 0; q < 16; ++q) { O[0][q] = 0.f; O[1][q] = 0.f; }
                const h16* pv = PV + ((size_t)((b * 32 + c) * 8 + h) * 64 + r) * 128 + 8 * hh;
#pragma unroll
                for (int ks = 0; ks < 8; ++ks)
#pragma unroll
                    for (int pt = 0; pt < 2; ++pt) { const h16x8 A = *(const h16x8*)(pv + (size_t)(pt * 32) * 128 + 16 * ks); O[pt] = __builtin_amdgcn_mfma_f32_32x32x16_f16(A, Cf[ks], O[pt], 0, 0, 0); }
                const float el = __expf(acs_l);
#pragma unroll
                for (int q = 0; q < 16; ++q) { Y[0][q] += O[0][q] * el; Y[1][q] += O[1][q] * el; }
            }
            float ss = 0.f;
#pragma unroll
            for (int pt = 0; pt < 2; ++pt)
#pragma unroll
                for (int q = 0; q < 4; ++q) { const int p0 = h * 64 + pt * 32 + 8 * q + 4 * hh;
                    const h16x4 xv = *(const h16x4*)(XC + ml * 1024 + p0), zv = *(const h16x4*)(PROJ + ml * NPROJ + C_Z + p0);
#pragma unroll
                    for (int e = 0; e < 4; ++e) { const float z = (float)zv[e]; const float u = (Y[pt][4 * q + e] + dsk * (float)xv[e]) * (z * __builtin_amdgcn_rcpf(1.f + __expf(-z))); Y[pt][4 * q + e] = u; ss += u * u; } }
            ss += __shfl_xor(ss, 32);
            if (hh == 0) part[h * 32 + r] = ss;
            __syncthreads();
            float tot = 0.f;
#pragma unroll
            for (int w = 0; w < 8; ++w) tot += part[w * 32 + r];
            const float rstd = rsqrtf(tot * (1.f / 512.f) + EPS);
#pragma unroll
            for (int pt = 0; pt < 2; ++pt)
#pragma unroll
                for (int q = 0; q < 4; ++q) { const int p0 = h * 64 + pt * 32 + 8 * q + 4 * hh; const f32x4 wv = *(const f32x4*)(args.in[I_SSMN] + p0);
                    u32x2 o; o.x = pk_h2(Y[pt][4 * q] * rstd * wv[0], Y[pt][4 * q + 1] * rstd * wv[1]); o.y = pk_h2(Y[pt][4 * q + 2] * rstd * wv[2], Y[pt][4 * q + 3] * rstd * wv[3]);
                    *(u32x2*)(MIX + ml * D + p0) = o; }
            __syncthreads();
        }
    }
    SEAM(6);
    if (IN(7)) {
        float* slab = (float*)((unsigned char*)out + (size_t)bx * (8 * T * 4));
        LAS unsigned* hist = (LAS unsigned*)(lds + wave * 8448);
        unsigned short* IDX = (unsigned short*)(ws + WS_IDX);
        const int r = lane & 31, hh = lane >> 5;
        for (int i = 0;; ++i) {
            const int rho = i * G + ((i & 1) ? G - 1 - bx : bx); if (rho >= NB * (T / 8)) break;
            const int b = rho & 1, tq0 = 8 * (T / 8 - 1 - (rho >> 1));
            const size_t mq0 = (size_t)b * T + tq0;
            const int tq = tq0 + wave, n = tq + 1;
            unsigned short* orow = IDX + (mq0 + wave) * TOPK;
            if (tq0 + 8 <= TOPK) {
#pragma unroll
                for (int e = 0; e < 4; ++e) { const int j = 4 * lane + e; orow[j] = (unsigned short)(j < n ? j : 0); }
                continue;
            }
            {
                h16x8 Af[2][4]; float wq[2][2][8];
#pragma unroll
                for (int tl = 0; tl < 2; ++tl) {
                    const int hd = (r & 3) + 4 * ((r >> 3) & 1), ql = 4 * tl + ((r >> 2) & 1) + 2 * (r >> 4);
#pragma unroll
                    for (int ks = 0; ks < 4; ++ks) Af[tl][ks] = *(const h16x8*)(PROJ + (mq0 + ql) * NPROJ + C_QI + hd * 64 + 16 * ks + 8 * hh);
#pragma unroll
                    for (int hf = 0; hf < 2; ++hf) { const float* wp = PF32 + (mq0 + 4 * tl + hh + 2 * hf) * 16 + 8;
#pragma unroll
                        for (int e = 0; e < 8; ++e) wq[tl][hf][e] = wp[e] * (0.35355339059327373f * 0.125f); }
                }
                const int ntile = (tq0 + 8 + 31) >> 5;
                for (int kt = wave; kt < ntile; kt += NWAVES) {
                    const h16* kp = PROJ + ((size_t)b * T + kt * 32 + r) * NPROJ + C_KI + 8 * hh;
                    h16x8 Bf[4];
#pragma unroll
                    for (int ks = 0; ks < 4; ++ks) Bf[ks] = *(const h16x8*)(kp + 16 * ks);
#pragma unroll
                    for (int tl = 0; tl < 2; ++tl) {
                        f32x16 Dv;
#pragma unroll
                        for (int q = 0; q < 16; ++q) Dv[q] = 0.f;
#pragma unroll
                        for (int ks = 0; ks < 4; ++ks) Dv = __builtin_amdgcn_mfma_f32_32x32x16_f16(Af[tl][ks], Bf[ks], Dv, 0, 0, 0);
#pragma unroll
                        for (int hf = 0; hf < 2; ++hf) { float sc = 0.f;
#pragma unroll
                            for (int e = 0; e < 8; ++e) sc += wq[tl][hf][e] * fmaxf(Dv[8 * hf + e], 0.f);
                            slab[(size_t)(4 * tl + hh + 2 * hf) * T + kt * 32 + r] = sc; }
                    }
                }
            }
            asm volatile("s_waitcnt vmcnt(0)" ::: "memory");
            __syncthreads();
            __builtin_amdgcn_fence(__ATOMIC_ACQUIRE, "agent");
            asm volatile("s_waitcnt vmcnt(0)" ::: "memory");
            {
                const float* row = slab + (size_t)wave * T;
                unsigned prefix = 0u, pmask = 0u; int need = TOPK;
#pragma unroll 1
                for (int lvl = 0; lvl < 3; ++lvl) {
                    const int sh = lvl == 0 ? 21 : (lvl == 1 ? 10 : 0); const unsigned bm = lvl == 2 ? 0x3ffu : 0x7ffu;
                    for (int k = lane; k < 2112; k += 64) hist[k] = 0u;
                    LDS_WAIT(); asm volatile("" ::: "memory");
                    for (int i0 = 0; i0 < n; i0 += 256) {
                        const f32x4 v = *(const f32x4*)(row + i0 + 4 * lane);
#pragma unroll
                        for (int e = 0; e < 4; ++e) { const unsigned key = fkey(v[e]); const unsigned bin = (key >> sh) & bm;
                            if (i0 + 4 * lane + e < n && (key & pmask) == prefix) __hip_atomic_fetch_add(&hist[bin + (bin >> 5)], 1u, __ATOMIC_RELAXED, __HIP_MEMORY_SCOPE_WORKGROUP); }
                    }
                    LDS_WAIT(); asm volatile("" ::: "memory");
                    unsigned own = 0u;
#pragma unroll
                    for (int k = 0; k < 32; ++k) own += hist[33 * lane + k];
                    unsigned suf = own;
#pragma unroll
                    for (int o = 1; o < 64; o <<= 1) { const unsigned u = __shfl_down(suf, o); if (lane + o < 64) suf += u; }
                    const unsigned long long mk = __ballot(suf >= (unsigned)need);
                    const int Ls = 63 - __builtin_clzll(mk);
                    unsigned cum = suf - own; int Bsel = 0; unsigned above = 0u; bool found = false;
#pragma unroll
                    for (int k = 31; k >= 0; --k) { const unsigned c = hist[33 * lane + k]; if (!found && cum + c >= (unsigned)need) { found = true; Bsel = k; above = cum; } cum += c; }
                    const int Bl = __shfl(Bsel, Ls); const unsigned ab = __shfl(above, Ls);
                    const unsigned bin = (unsigned)(32 * Ls + Bl);
                    prefix |= bin << sh; pmask |= bm << sh; need -= (int)ab;
                }
                const unsigned Kt = prefix; unsigned base_gt = 0u, base_tie = 0u;
                for (int i0 = 0; i0 < n; i0 += 256) {
                    const f32x4 v = *(const f32x4*)(row + i0 + 4 * lane);
                    unsigned kk[4]; unsigned cg = 0u, ct = 0u;
#pragma unroll
                    for (int e = 0; e < 4; ++e) { kk[e] = (i0 + 4 * lane + e < n) ? fkey(v[e]) : 0u; cg += (kk[e] > Kt); ct += (kk[e] == Kt); }
                    unsigned pk = (ct << 16) | cg, inc = pk;
#pragma unroll
                    for (int o = 1; o < 64; o <<= 1) { const unsigned u = __shfl_up(inc, o); if (lane >= o) inc += u; }
                    const unsigned exc = inc - pk, tot = __shfl(inc, 63);
                    unsigned gt_before = base_gt + (exc & 0xffffu), tie_before = base_tie + (exc >> 16);
                    unsigned pos = gt_before + (tie_before < (unsigned)need ? tie_before : (unsigned)need);
#pragma unroll
                    for (int e = 0; e < 4; ++e) { bool s = kk[e] > Kt; if (kk[e] == Kt) { s = tie_before < (unsigned)need; ++tie_before; }
                        if (s) { orow[pos] = (unsigned short)(i0 + 4 * lane + e); ++pos; } }
                    base_gt += tot & 0xffffu; base_tie += tot >> 16;
                }
            }
            __syncthreads();
        }
    }
    SEAM(7);
    if (IN(9)) {
        pg8::Gemm g{MIX, WOUT, M, D, D}; pg8::StaticOrder S; S.init(M, D, G, bx);
        pg8::EpiF32 E{MIXO, D};
        pg8::gemm_phase<pg8::EpiF32, pg8::StaticOrder, true, true>(lds, g, S, E);
    }
    SEAM(9);
    if (IN(10)) {
        const float* w1p = args.in[I_N1POST]; const float* w2p = args.in[I_N2PRE];
        for (int m = gw; m < M; m += NGW) {
            const int b = m / T; const float* md = MOD + (size_t)b * 6 * D; const f32x4* mr = (const f32x4*)(MIXO + (size_t)m * D) + lane; const f32x4* xr = (const f32x4*)(x + (size_t)m * D) + lane;
            f32x4 v[4]; float ss = 0.f;
#pragma unroll
            for (int j = 0; j < 4; ++j) { v[j] = mr[64 * j]; ss += (v[j].x * v[j].x + v[j].y * v[j].y) + (v[j].z * v[j].z + v[j].w * v[j].w); }
            float rstd = rsqrtf(wave_sum(ss) * (1.f / D) + EPS); ss = 0.f;
            f32x4* orow = (f32x4*)(out + (size_t)m * D) + lane;
#pragma unroll
            for (int j = 0; j < 4; ++j) { const int k = 4 * lane + 256 * j; const f32x4 gt = *(const f32x4*)(md + 2 * D + k), wp = *(const f32x4*)(w1p + k);
                v[j] = xr[64 * j] + gt * (v[j] * rstd * wp); orow[64 * j] = v[j]; ss += (v[j].x * v[j].x + v[j].y * v[j].y) + (v[j].z * v[j].z + v[j].w * v[j].w); }
            rstd = rsqrtf(wave_sum(ss) * (1.f / D) + EPS);
            u32x2* o8 = (u32x2*)(XN + (size_t)m * D) + lane;
#pragma unroll
            for (int j = 0; j < 4; ++j) { const int k = 4 * lane + 256 * j; const f32x4 gg = *(const f32x4*)(w2p + k), sh = *(const f32x4*)(md + 3 * D + k), sc = *(const f32x4*)(md + 4 * D + k);
                const f32x4 r = v[j] * rstd * gg * (sc + 1.f) + sh; u32x2 w; w.x = pk_h2(r.x, r.y); w.y = pk_h2(r.z, r.w); o8[64 * j] = w; }
        }
    }
    SEAM(10);
    if (IN(11)) {
        pg8::Gemm g{XN, W1, M, FF, D}; pg8::StaticOrder S; S.init(M, FF, G, bx);
        pg8::EpiH16<1, false> E{HB, FF, nullptr};
        pg8::gemm_phase<pg8::EpiH16<1, false>, pg8::StaticOrder, true, true>(lds, g, S, E);
    }
    SEAM(11);
    if (IN(12)) {
        pg8::Gemm g{HB, W2, M, D, FF}; pg8::StaticOrder S; S.init(M, D, G, bx);
        pg8::EpiF32 E{FB, D};
        pg8::gemm_phase<pg8::EpiF32, pg8::StaticOrder, true, true>(lds, g, S, E);
    }
    SEAM(12);
    if (IN(13)) {
        const float* w2post = args.in[I_N2POST];
        for (int m = gw; m < M; m += NGW) {
            const int b = m / T; const float* md = MOD + (size_t)b * 6 * D; const f32x4* fr = (const f32x4*)(FB + (size_t)m * D) + lane;
            f32x4 v[4]; float ss = 0.f;
#pragma unroll
            for (int j = 0; j < 4; ++j) { v[j] = fr[64 * j]; ss += (v[j].x * v[j].x + v[j].y * v[j].y) + (v[j].z * v[j].z + v[j].w * v[j].w); }
            const float rstd = rsqrtf(wave_sum(ss) * (1.f / D) + EPS);
            f32x4* orow = (f32x4*)(out + (size_t)m * D) + lane;
#pragma unroll
            for (int j = 0; j < 4; ++j) { const int k = 4 * lane + 256 * j; const f32x4 gt = *(const f32x4*)(md + 5 * D + k), wp = *(const f32x4*)(w2post + k);
                orow[64 * j] = orow[64 * j] + gt * (v[j] * rstd * wp); }
        }
    }
#undef IN
#undef SEAM
}

static int g_grid = 0;
static void mk_launch(Args& a, int lo, int hi, int li, hipStream_t stream) {
    a.ph_lo = lo; a.ph_hi = hi; a.li = li;
    hipLaunchKernelGGL(mk_fwd, dim3(g_grid), dim3(NTHR), LDS_BYTES, stream, a);
}

extern "C" void kernel_launch(void* const* d_in, const int* in_sizes, int n_in, void* d_out, int out_size, void* d_ws, size_t ws_size, hipStream_t stream) {
    const float* x = (const float*)d_in[0]; const float* c = (const float*)d_in[1]; const float* w_ada = (const float*)d_in[2]; const float* b_ada = (const float*)d_in[3];
    const float* norm1_pre = (const float*)d_in[4]; const float* norm1_post = (const float*)d_in[5]; const float* w_in = (const float*)d_in[6];
    const float* conv_w = (const float*)d_in[7]; const float* conv_b = (const float*)d_in[8]; const float* dt_bias = (const float*)d_in[9];
    const float* a_log = (const float*)d_in[10]; const float* d_skip = (const float*)d_in[11]; const float* ssm_norm = (const float*)d_in[12];
    const float* rel_bias = (const float*)d_in[13]; const float* attn_norm = (const float*)d_in[14]; const float* w_out = (const float*)d_in[15];
    const float* norm2_pre = (const float*)d_in[16]; const float* norm2_post = (const float*)d_in[17]; const float* w_mlp_in = (const float*)d_in[18]; const float* w_mlp_out = (const float*)d_in[19];
    unsigned char* ws = (unsigned char*)d_ws; unsigned char* dob = (unsigned char*)d_out; float* out = (float*)d_out;
    float* MOD = (float*)(ws + WS_MOD); float* PF32 = (float*)(ws + WS_PF32);
    h16* WIN = (h16*)(ws + WS_WIN); h16* WOUT = (h16*)(ws + WS_WOUT); h16* W1 = (h16*)(ws + WS_W1); h16* W2 = (h16*)(ws + WS_W2);
    h16* XN = (h16*)(ws + WS_XN); h16* PROJ = (h16*)(ws + WS_PROJ); h16* MIX = (h16*)(ws + WS_MIX); unsigned short* IDX = (unsigned short*)(ws + WS_IDX);
    float* YTMP = (float*)(ws + WS_YTMP); float* DTV = (float*)(ws + WS_DT); float* MIXO = (float*)(ws + WS_MIXO); h16* HB = (h16*)(ws + WS_H); float* FB = (float*)(ws + WS_F);
    h16* XC = (h16*)(dob + DO_XC); float* SLAB = (float*)dob;

    if (g_grid == 0) {
        int dev = 0, cus = 0;
        if (hipGetDevice(&dev) != hipSuccess || hipDeviceGetAttribute(&cus, hipDeviceAttributeMultiprocessorCount, dev) != hipSuccess) { fprintf(stderr, "kernel_launch: device query failed\n"); g_grid = -1; return; }
        if (hipFuncSetAttribute((const void*)mk_fwd, hipFuncAttributeMaxDynamicSharedMemorySize, LDS_BYTES) != hipSuccess) { fprintf(stderr, "kernel_launch: hipFuncSetAttribute failed\n"); g_grid = -1; return; }
        g_grid = cus;
        if (ws_size < 256 * MiB) fprintf(stderr, "kernel_launch: workspace too small: %zu\n", ws_size);
    }
    if (g_grid < 0) return;
    (void)hipMemsetAsync(ws + WS_CTL, 0, CTL_ZERO_BYTES, stream);
    Args a{};
    for (int i = 0; i < 20; ++i) a.in[i] = (const float*)d_in[i];
    a.out = out; a.ws = ws;
    int li = 0;
    mk_launch(a, 0, 3, li++, stream);
    mk_launch(a, 3, 7, li++, stream);
    mk_launch(a, 7, 8, li++, stream);
    nv::attn<<<M * 8 / 256, 256, 0, stream>>>(PROJ, IDX, rel_bias, YTMP);
    nv::norm512<<<M / 4, 256, 0, stream>>>(YTMP, PROJ, 0, attn_norm, MIX, 512);
    mk_launch(a, 9, 14, li++, stream);
}
```

```cpp
#include <hip/hip_runtime.h>
#include <cstdio>
#include <cstdint>

typedef _Float16 h16;
typedef _Float16 h16x4 __attribute__((ext_vector_type(4)));
typedef _Float16 h16x8 __attribute__((ext_vector_type(8)));
typedef float f32x4 __attribute__((ext_vector_type(4)));

constexpr int NB = 2, T = 8192, D = 1024, M = NB * T, FF = 4096;
constexpr int NPROJ = 3072;
constexpr int C_Z = 0, C_XBC = 512, C_Q = 1536, C_K = 2048, C_V = 2176, C_QI = 2304, C_KI = 2816, C_DT = 2880, C_WI = 2888, C_END = 2896;
constexpr float EPS = 1e-6f;
constexpr int TOPK = 256;

constexpr size_t MiB = 1u << 20;
constexpr size_t WS_CTL = 0, WS_MOD = 1 * MiB, WS_PF32 = 2 * MiB;
constexpr size_t WS_WIN = 4 * MiB, WS_WOUT = 10 * MiB, WS_W1 = 12 * MiB, WS_W2 = 20 * MiB;
constexpr size_t WS_XN = 28 * MiB, WS_PROJ = 60 * MiB;
constexpr size_t WS_STATES = 156 * MiB, WS_PREV = 172 * MiB, WS_DT = 180 * MiB, WS_ACS = WS_DT + 512 * 1024;
constexpr size_t WS_MIX = 181 * MiB, WS_IDX = 213 * MiB, WS_YTMP = 221 * MiB;
constexpr size_t WS_MIXO = 60 * MiB, WS_H = 60 * MiB, WS_F = 188 * MiB;
constexpr size_t DO_XC = 0, DO_XST = 32 * MiB, DO_BT = 48 * MiB;

__device__ __forceinline__ float silu_f(float x) { return x / (1.f + __expf(-x)); }
__device__ __forceinline__ float softplus_f(float x) { return fmaxf(x, 0.f) + log1pf(__expf(-fabsf(x))); }
__device__ __forceinline__ float wave_sum(float v) {
#pragma unroll
    for (int o = 1; o < 64; o <<= 1) v += __shfl_xor(v, o);
    return v;
}
__device__ __forceinline__ int win_src(int n) {
    if (n < C_Q) return n;
    if (n < C_DT) return n + 8;
    if (n < C_WI) return n - C_DT + 1536;
    if (n < C_END) return n;
    return -1;
}
__device__ __forceinline__ int t5_bucket(int n) {
    if (n < 16) return n;
    int b = 16;
    b += (n >= 19); b += (n >= 21); b += (n >= 24); b += (n >= 27); b += (n >= 31); b += (n >= 35); b += (n >= 40); b += (n >= 46);
    b += (n >= 52); b += (n >= 59); b += (n >= 67); b += (n >= 77); b += (n >= 87); b += (n >= 99); b += (n >= 113);
    return b;
}
__device__ __forceinline__ unsigned fkey(float f) { unsigned u = __float_as_uint(f); return (u & 0x80000000u) ? ~u : (u | 0x80000000u); }

namespace nv {
__global__ void prep_w(const float* W, int K, int N, h16* WT, int NT, int mode) {
    const size_t i = (size_t)blockIdx.x * blockDim.x + threadIdx.x; if (i >= (size_t)NT * K) return;
    const int n = (int)(i / K), k = (int)(i % K); const int s = mode ? win_src(n) : n;
    WT[i] = (h16)(s < 0 ? 0.f : W[(size_t)k * N + s]);
}
__global__ void modk(const float* c, const float* w_ada, const float* b_ada, float* mod) {
    const int j = blockIdx.x * blockDim.x + threadIdx.x; if (j >= NB * 6 * D) return;
    const int b = j / (6 * D), jj = j % (6 * D); float acc = b_ada[jj];
    for (int k = 0; k < D; ++k) acc += silu_f(c[b * D + k]) * w_ada[(size_t)k * 6 * D + jj];
    mod[j] = acc;
}
__global__ void norm_mod(const float* x, const float* g, const float* mod, int ci, h16* xn) {
    const int m = blockIdx.x * (blockDim.x / 64) + (threadIdx.x >> 6), lane = threadIdx.x & 63; if (m >= M) return;
    const int b = m / T; const float* xr = x + (size_t)m * D; float v[16]; float ss = 0.f;
#pragma unroll
    for (int j = 0; j < 16; ++j) { v[j] = xr[lane + 64 * j]; ss += v[j] * v[j]; }
    const float rstd = rsqrtf(wave_sum(ss) * (1.f / D) + EPS);
    const float* sh = mod + (size_t)b * 6 * D + ci * D; const float* sc = sh + D;
#pragma unroll
    for (int j = 0; j < 16; ++j) { const int k = lane + 64 * j; xn[(size_t)m * D + k] = (h16)(v[j] * rstd * g[k] * (1.f + sc[k]) + sh[k]); }
}
struct EpiProj { h16* proj; float* pf32;
    __device__ void operator()(int m, int n, float v) const { proj[(size_t)m * NPROJ + n] = (h16)v; if (n >= C_DT && n < C_END) pf32[(size_t)m * 16 + (n - C_DT)] = v; } };
struct EpiF32 { float* C; int ldc; __device__ void operator()(int m, int n, float v) const { C[(size_t)m * ldc + n] = v; } };
struct EpiRelu2 { h16* C; int ldc; __device__ void operator()(int m, int n, float v) const { const float r = fmaxf(v, 0.f); C[(size_t)m * ldc + n] = (h16)(r * r); } };
template <class Epi> __global__ void __launch_bounds__(256) gemm(const h16* A, const h16* Bt, int Mm, int N, int K, Epi epi) {
    __shared__ float As[16][65], Bs[16][65];
    const int tid = threadIdx.x, tx = tid & 15, ty = tid >> 4, m0 = blockIdx.y * 64, n0 = blockIdx.x * 64;
    float acc[4][4] = {};
    const int lr = tid >> 2, lk = (tid & 3) * 4;
    for (int k0 = 0; k0 < K; k0 += 16) {
        const h16x4 a = *(const h16x4*)(A + (size_t)(m0 + lr) * K + k0 + lk), b = *(const h16x4*)(Bt + (size_t)(n0 + lr) * K + k0 + lk);
#pragma unroll
        for (int j = 0; j < 4; ++j) { As[lk + j][lr] = (float)a[j]; Bs[lk + j][lr] = (float)b[j]; }
        __syncthreads();
#pragma unroll
        for (int k = 0; k < 16; ++k) { float av[4], bv[4];
#pragma unroll
            for (int i = 0; i < 4; ++i) { av[i] = As[k][ty * 4 + i]; bv[i] = Bs[k][tx * 4 + i]; }
#pragma unroll
            for (int i = 0; i < 4; ++i)
#pragma unroll
                for (int j = 0; j < 4; ++j) acc[i][j] += av[i] * bv[j]; }
        __syncthreads();
    }
#pragma unroll
    for (int i = 0; i < 4; ++i)
#pragma unroll
        for (int j = 0; j < 4; ++j) epi(m0 + ty * 4 + i, n0 + tx * 4 + j, acc[i][j]);
}
__global__ void conv(const h16* proj, const float* pf32, const float* cw, const float* cb, const float* dt_bias, h16* xc, float* dtv) {
    const size_t i = (size_t)blockIdx.x * blockDim.x + threadIdx.x; if (i >= (size_t)M * 1024) return;
    const int m = (int)(i >> 10), ch = (int)(i & 1023), t = m % T; float acc = cb[ch];
#pragma unroll
    for (int w = 0; w < 4; ++w) { const int tt = t - 3 + w; if (tt >= 0) acc += cw[w * 1024 + ch] * (float)proj[(size_t)(m - 3 + w) * NPROJ + C_XBC + ch]; }
    xc[i] = (h16)silu_f(acc);
    if (ch < 8) dtv[(size_t)m * 8 + ch] = softplus_f(pf32[(size_t)m * 16 + ch] + dt_bias[ch]);
}
__global__ void __launch_bounds__(64) ssd_rec(const h16* xc, const float* dtv, const float* a_log, const float* d_skip, float* y) {
    const int b = blockIdx.x / 8, h = blockIdx.x % 8, g = h / 4, p = threadIdx.x;
    const float a = -__expf(a_log[h]), dsk = d_skip[h]; float st[128];
#pragma unroll
    for (int n = 0; n < 128; ++n) st[n] = 0.f;
    for (int t = 0; t < T; ++t) {
        const size_t m = (size_t)b * T + t; const float dt = dtv[m * 8 + h], dA = __expf(a * dt), xs = (float)xc[m * 1024 + h * 64 + p], xdt = xs * dt;
        const h16* Bp = xc + m * 1024 + 512 + g * 128; const h16* Cp = xc + m * 1024 + 768 + g * 128; float acc = 0.f;
#pragma unroll
        for (int n = 0; n < 128; ++n) { st[n] = st[n] * dA + (float)Bp[n] * xdt; acc += (float)Cp[n] * st[n]; }
        y[m * 512 + h * 64 + p] = acc + dsk * xs;
    }
}
__global__ void norm512(const float* y, const h16* proj, int gate, const float* w, h16* mix, int coff) {
    const int m = blockIdx.x * (blockDim.x / 64) + (threadIdx.x >> 6), lane = threadIdx.x & 63; if (m >= M) return;
    float v[8]; float ss = 0.f;
#pragma unroll
    for (int j = 0; j < 8; ++j) { const int k = lane + 64 * j; float u = y[(size_t)m * 512 + k]; if (gate) u *= silu_f((float)proj[(size_t)m * NPROJ + C_Z + k]); v[j] = u; ss += u * u; }
    const float rstd = rsqrtf(wave_sum(ss) * (1.f / 512.f) + EPS);
#pragma unroll
    for (int j = 0; j < 8; ++j) { const int k = lane + 64 * j; mix[(size_t)m * D + coff + k] = (h16)(v[j] * rstd * w[k]); }
}
__global__ void __launch_bounds__(256) scores(const h16* proj, const float* pf32, int q0, float* slab) {
    __shared__ float qs[512]; __shared__ float ws[8];
    const int ql = blockIdx.y, m = q0 + ql, t = m % T, b = m / T, s = blockIdx.x * 256 + threadIdx.x;
    if (blockIdx.x * 256 > t) return;
    for (int i = threadIdx.x; i < 512; i += 256) qs[i] = (float)proj[(size_t)m * NPROJ + C_QI + i];
    if (threadIdx.x < 8) ws[threadIdx.x] = pf32[(size_t)m * 16 + 8 + threadIdx.x] * 0.35355339059327373f * 0.125f;
    __syncthreads();
    float kv[64]; const h16* kp = proj + (size_t)(b * T + s) * NPROJ + C_KI;
#pragma unroll
    for (int d = 0; d < 64; ++d) kv[d] = (float)kp[d];
    float sc = 0.f;
    for (int h = 0; h < 8; ++h) { float dot = 0.f;
#pragma unroll
        for (int d = 0; d < 64; ++d) dot += qs[h * 64 + d] * kv[d];
        sc += ws[h] * fmaxf(dot, 0.f); }
    slab[(size_t)ql * T + s] = sc;
}
__global__ void __launch_bounds__(256) select(const float* slab, int q0, unsigned short* idx) {
    __shared__ unsigned red[256]; __shared__ unsigned sh_cnt;
    const int ql = blockIdx.x, m = q0 + ql, t = m % T, n = t + 1, tid = threadIdx.x;
    unsigned short* out = idx + (size_t)m * TOPK;
    if (n <= TOPK) { out[tid] = (unsigned short)(tid < n ? tid : 0); return; }
    unsigned key[32];
#pragma unroll
    for (int j = 0; j < 32; ++j) { const int i = tid * 32 + j; key[j] = i < n ? fkey(slab[(size_t)ql * T + i]) : 0u; }
    unsigned Kt = 0u;
    for (int bit = 31; bit >= 0; --bit) {
        const unsigned cand = Kt | (1u << bit); unsigned c = 0;
#pragma unroll
        for (int j = 0; j < 32; ++j) c += (key[j] >= cand);
        if (tid == 0) sh_cnt = 0u; __syncthreads();
        atomicAdd(&sh_cnt, c); __syncthreads();
        if (sh_cnt >= (unsigned)TOPK) Kt = cand;
        __syncthreads();
    }
    unsigned cg = 0, ce = 0;
#pragma unroll
    for (int j = 0; j < 32; ++j) { cg += (key[j] > Kt); ce += (key[j] == Kt); }
    red[tid] = (cg << 16) | ce; __syncthreads();
    unsigned pg = 0, pe = 0, tg = 0;
    for (int i = 0; i < 256; ++i) { const unsigned r = red[i]; if (i < tid) { pg += r >> 16; pe += r & 0xffffu; } tg += r >> 16; }
    const unsigned need = (unsigned)TOPK - tg;
    unsigned sel_before = pg + (pe < need ? pe : need);
#pragma unroll
    for (int j = 0; j < 32; ++j) {
        bool s = false;
        if (key[j] > Kt) s = true; else if (key[j] == Kt) { s = pe < need; ++pe; }
        if (s) { out[sel_before] = (unsigned short)(tid * 32 + j); ++sel_before; }
    }
}
__global__ void __launch_bounds__(256) attn(const h16* proj, const unsigned short* idx, const float* rel_bias, float* y) {
    const int gid = blockIdx.x * 256 + threadIdx.x, m = gid >> 3, h = gid & 7, g = h >> 2, t = m % T, b = m / T;
    const int cnt = (t + 1 < TOPK) ? t + 1 : TOPK;
    float q[64], acc[64];
#pragma unroll
    for (int d = 0; d < 64; ++d) { q[d] = (float)proj[(size_t)m * NPROJ + C_Q + h * 64 + d] * 0.125f; acc[d] = 0.f; }
    float mx = -INFINITY, l = 0.f;
    for (int j = 0; j < cnt; ++j) {
        const int s = idx[(size_t)m * TOPK + j]; const h16* kp = proj + (size_t)(b * T + s) * NPROJ + C_K + g * 64; const h16* vp = kp + (C_V - C_K);
        float lg = rel_bias[t5_bucket(t - s) * 8 + h];
#pragma unroll
        for (int d = 0; d < 64; ++d) lg += q[d] * (float)kp[d];
        const float mn = fmaxf(mx, lg), sc = __expf(mx - mn), pe = __expf(lg - mn);
        l = l * sc + pe; mx = mn;
#pragma unroll
        for (int d = 0; d < 64; ++d) acc[d] = acc[d] * sc + pe * (float)vp[d];
    }
    const float inv = 1.f / l;
#pragma unroll
    for (int d = 0; d < 64; ++d) y[(size_t)m * 512 + h * 64 + d] = acc[d] * inv;
}
__global__ void post1(const float* x, const float* mixo, const float* mod, const float* w1post, const float* w2pre, float* out, h16* xn) {
    const int m = blockIdx.x * (blockDim.x / 64) + (threadIdx.x >> 6), lane = threadIdx.x & 63; if (m >= M) return;
    const int b = m / T; const float* md = mod + (size_t)b * 6 * D; float v[16]; float ss = 0.f;
#pragma unroll
    for (int j = 0; j < 16; ++j) { v[j] = mixo[(size_t)m * D + lane + 64 * j]; ss += v[j] * v[j]; }
    float rstd = rsqrtf(wave_sum(ss) * (1.f / D) + EPS); ss = 0.f;
#pragma unroll
    for (int j = 0; j < 16; ++j) { const int k = lane + 64 * j; v[j] = x[(size_t)m * D + k] + md[2 * D + k] * (v[j] * rstd * w1post[k]); out[(size_t)m * D + k] = v[j]; ss += v[j] * v[j]; }
    rstd = rsqrtf(wave_sum(ss) * (1.f / D) + EPS);
#pragma unroll
    for (int j = 0; j < 16; ++j) { const int k = lane + 64 * j; xn[(size_t)m * D + k] = (h16)(v[j] * rstd * w2pre[k] * (1.f + md[4 * D + k]) + md[3 * D + k]); }
}
__global__ void post2(const float* f, const float* mod, const float* w2post, float* out) {
    const int m = blockIdx.x * (blockDim.x / 64) + (threadIdx.x >> 6), lane = threadIdx.x & 63; if (m >= M) return;
    const int b = m / T; const float* md = mod + (size_t)b * 6 * D; float v[16]; float ss = 0.f;
#pragma unroll
    for (int j = 0; j < 16; ++j) { v[j] = f[(size_t)m * D + lane + 64 * j]; ss += v[j] * v[j]; }
    const float rstd = rsqrtf(wave_sum(ss) * (1.f / D) + EPS);
#pragma unroll
    for (int j = 0; j < 16; ++j) { const int k = lane + 64 * j; out[(size_t)m * D + k] += md[5 * D + k] * (v[j] * rstd * w2post[k]); }
}
}


#define LAS __attribute__((address_space(3)))
#define GAS __attribute__((address_space(1)))
typedef unsigned u32x4 __attribute__((ext_vector_type(4)));
typedef unsigned u32x2 __attribute__((ext_vector_type(2)));
typedef float f32x2 __attribute__((ext_vector_type(2)));
typedef _Float16 h16x2 __attribute__((ext_vector_type(2)));
typedef float f32x16 __attribute__((ext_vector_type(16)));
__device__ __forceinline__ unsigned pk_h2(float lo, float hi) { const f32x2 v = {lo, hi}; const h16x2 h = __builtin_convertvector(v, h16x2); return __builtin_bit_cast(unsigned, h); }

namespace pg8 {
constexpr int BM = 256, BK = 64, HALF = 128, HTB = HALF * BK * 2, STAGE_BYTES = 8 * HTB, NXCD = 8, WGM = 8;
__host__ __device__ __forceinline__ int lds_byte(int r, int c) { const int st = (r >> 4) * 2 + (c >> 5), rr = r & 15, cc = c & 31, ob = rr * 64 + cc * 2; return st * 1024 + (ob ^ (((ob >> 9) & 1) << 5)); }
__host__ __device__ __forceinline__ void stage_rc(int b, int& R, int& C) { const int st = b / 1024, sb = b % 1024, swz = sb ^ (((sb >> 9) & 1) << 5); R = (st >> 1) * 16 + swz / 64; C = (st & 1) * 32 + (swz % 64) / 2; }
__host__ __device__ __forceinline__ int perm32(int rho) { const int n = rho >> 4, i = rho & 15; return 8 * (i >> 2) + 4 * n + (i & 3); }
struct Unit { int pm, pn; };
struct Gemm { const h16* A; const h16* Bt; int M, N, K; };
struct StaticOrder {
    int nM, nN, nwg, G, c;
    __host__ __device__ void init(int M_, int N_, int G_, int c_) { nM = M_ / BM; nN = N_ / BM; nwg = nM * nN; G = G_; c = c_; }
    __host__ __device__ bool next(int i, Unit& u) const {
        const long L = (long)i * G + c; if (L >= nwg) return false;
        int wgid = (int)L; { const int q = nwg / NXCD, r = nwg % NXCD, xcd = wgid % NXCD, off = wgid / NXCD; wgid = (xcd < r ? xcd * (q + 1) : r * (q + 1) + (xcd - r) * q) + off; }
        const int nig = WGM * nN, gid = wgid / nig, fm = gid * WGM, gsz = (nM - fm) < WGM ? (nM - fm) : WGM;
        u.pm = fm + ((wgid % nig) % gsz); u.pn = (wgid % nig) / gsz; return true;
    }
    __device__ __forceinline__ void a_ready(const Unit&) const {}
    __device__ __forceinline__ void done(const Unit&) const {}
};
struct EpiF32 {
    static constexpr bool PERM = false, AFTER_DRAIN = false;
    float* C; int ldc;
    __device__ __forceinline__ void operator()(const f32x4 (&acc)[2][2][4][2], const Unit& u, int wr, int wc, int fr, int fq) const {
        const int row0 = u.pm * BM + wr * 64 + fr, col0 = u.pn * BM + wc * 32 + 4 * fq;
#pragma unroll
        for (int ai = 0; ai < 2; ++ai)
#pragma unroll
            for (int m = 0; m < 4; ++m) { float* rowp = C + (size_t)(row0 + ai * HALF + m * 16) * ldc + col0;
#pragma unroll
                for (int bj = 0; bj < 2; ++bj)
#pragma unroll
                    for (int n = 0; n < 2; ++n) *(f32x4*)(rowp + bj * HALF + n * 16) = acc[ai][bj][m][n]; }
    }
};
template <int ACT  , bool SIDE  > struct EpiH16 {
    static constexpr bool PERM = true, AFTER_DRAIN = false;
    h16* O; int ldc; float* pf32;
    __device__ __forceinline__ void operator()(const f32x4 (&acc)[2][2][4][2], const Unit& u, int wr, int wc, int fr, int fq) const {
        const int row0 = u.pm * BM + wr * 64 + fr, col0 = u.pn * BM + wc * 32 + 8 * fq;
#pragma unroll
        for (int ai = 0; ai < 2; ++ai)
#pragma unroll
            for (int m = 0; m < 4; ++m) { h16* rowp = O + (size_t)(row0 + ai * HALF + m * 16) * ldc + col0;
#pragma unroll
                for (int bj = 0; bj < 2; ++bj) { f32x4 v0 = acc[ai][bj][m][0], v1 = acc[ai][bj][m][1];
                    if (ACT == 1) {
#pragma unroll
                        for (int j = 0; j < 4; ++j) { const float a = fmaxf(v0[j], 0.f), b = fmaxf(v1[j], 0.f); v0[j] = a * a; v1[j] = b * b; } }
                    u32x4 w; w.x = pk_h2(v0[0], v0[1]); w.y = pk_h2(v0[2], v0[3]); w.z = pk_h2(v1[0], v1[1]); w.w = pk_h2(v1[2], v1[3]);
                    *(u32x4*)(rowp + bj * HALF) = w;
                    if (SIDE) { if (bj == 0 && u.pn * BM + 64 == C_DT && wc == 2 && fq < 2) {
                        float* sp = pf32 + (size_t)(row0 + ai * HALF + m * 16) * 16 + 8 * fq; *(f32x4*)sp = acc[ai][0][m][0]; *(f32x4*)(sp + 4) = acc[ai][0][m][1]; } }
                } }
    }
};
template <class Epi, class Sched, bool ALIGN_EPI = false, bool SP2 = false>
__device__ __forceinline__ void gemm_phase(LAS unsigned char* lds, const Gemm g, const Sched& S, const Epi& E) {
    const int tid = threadIdx.x, wid = __builtin_amdgcn_readfirstlane(tid >> 6), lane = tid & 63, wr = wid >> 2, wc = wid & 3, fr = lane & 15, fq = lane >> 4;
    const int K = g.K, nt = K / BK;
    unsigned voffA[2], voffB[2];
#pragma unroll
    for (int i = 0; i < 2; ++i) { int R, C; stage_rc(tid * 16 + i * 8192, R, C); const int Rb = Epi::PERM ? ((R & ~31) + perm32(R & 31)) : R;
        voffA[i] = (unsigned)(R * K + C) * 2u; voffB[i] = (unsigned)(Rb * K + C) * 2u; }
    const size_t kstep = (size_t)(BK * 2);
    const size_t hstep = (size_t)HALF * K * 2;
    const size_t tstep = 2 * hstep;
    const unsigned ldsw = (unsigned)wid * 1024u;
    const int aoff = lds_byte(wr * 64 + fr, fq * 8), boff = lds_byte(wc * 32 + fr, fq * 8);
#define PG8_SA(b, h) (((b) * 2 + (h)) * HTB)
#define PG8_SB(b, h) ((4 + (b) * 2 + (h)) * HTB)
#define PG8_STAGE(bufoff, gbase, voff) do { _Pragma("unroll") for (int _i = 0; _i < 2; ++_i) \
        __builtin_amdgcn_global_load_lds((const unsigned*)((const char*)(gbase) + (voff)[_i]), (LAS unsigned*)(lds + (bufoff) + ldsw + _i * 8192), 16, 0, 0); } while (0)
#define PG8_LDA(dst, b, h) do { _Pragma("unroll") for (int m = 0; m < 4; ++m) _Pragma("unroll") for (int k = 0; k < 2; ++k) dst[m][k] = *(const LAS h16x8*)(lds + PG8_SA(b, h) + aoff + m * 2048 + k * 1024); } while (0)
#define PG8_LDB(dst, b, h) do { _Pragma("unroll") for (int n = 0; n < 2; ++n) _Pragma("unroll") for (int k = 0; k < 2; ++k) dst[n][k] = *(const LAS h16x8*)(lds + PG8_SB(b, h) + boff + n * 2048 + k * 1024); } while (0)
#define PG8_MMA(ai, bj, At, Bt) do { __builtin_amdgcn_s_setprio(1); _Pragma("unroll") for (int m = 0; m < 4; ++m) _Pragma("unroll") for (int n = 0; n < 2; ++n) _Pragma("unroll") for (int k = 0; k < 2; ++k) \
        acc[ai][bj][m][n] = __builtin_amdgcn_mfma_f32_16x16x32_f16(Bt[n][k], At[m][k], acc[ai][bj][m][n], 0, 0, 0); __builtin_amdgcn_s_setprio(0); } while (0)
#define PG8_WAIT_V(n) asm volatile("s_waitcnt vmcnt(" #n ")" ::: "memory")
#define PG8_WAIT_L(n) asm volatile("s_waitcnt lgkmcnt(" #n ")" ::: "memory")
#define PG8_BAR __builtin_amdgcn_s_barrier()
#define PG8_SCHED __builtin_amdgcn_sched_barrier(0)
    Unit cur, nxt; int ui = 0;
    if (!S.next(0, cur)) return;
    f32x4 acc[2][2][4][2];
#pragma unroll
    for (int a = 0; a < 2; ++a)
#pragma unroll
        for (int b = 0; b < 2; ++b)
#pragma unroll
            for (int m = 0; m < 4; ++m)
#pragma unroll
                for (int n = 0; n < 2; ++n) acc[a][b][m][n] = (f32x4){0.f, 0.f, 0.f, 0.f};
    h16x8 At[4][2], B0[2][2], B1[2][2];
    const char* cA = (const char*)g.A + (size_t)cur.pm * tstep; const char* cB = (const char*)g.Bt + (size_t)cur.pn * tstep;
    S.a_ready(cur);
    if constexpr (SP2) {
        PG8_STAGE(PG8_SB(0, 0), cB, voffB); PG8_STAGE(PG8_SB(0, 1), cB + hstep, voffB); PG8_STAGE(PG8_SA(0, 0), cA, voffA); PG8_STAGE(PG8_SA(0, 1), cA + hstep, voffA);
        if (wr == 1) PG8_BAR;
        PG8_WAIT_V(2); PG8_BAR;
        PG8_STAGE(PG8_SB(1, 0), cB + kstep, voffB); PG8_STAGE(PG8_SA(1, 0), cA + kstep, voffA); PG8_STAGE(PG8_SB(1, 1), cB + hstep + kstep, voffB);
        PG8_WAIT_V(6); PG8_BAR;
    } else {
        PG8_STAGE(PG8_SB(0, 0), cB, voffB); PG8_STAGE(PG8_SA(0, 0), cA, voffA); PG8_STAGE(PG8_SB(0, 1), cB + hstep, voffB); PG8_STAGE(PG8_SA(0, 1), cA + hstep, voffA);
        if (wr == 1) PG8_BAR;
        PG8_WAIT_V(4); PG8_BAR;
        PG8_STAGE(PG8_SB(1, 0), cB + kstep, voffB); PG8_STAGE(PG8_SA(1, 0), cA + kstep, voffA); PG8_STAGE(PG8_SB(1, 1), cB + hstep + kstep, voffB);
        PG8_WAIT_V(6); PG8_BAR;
    }
    for (;;) {
        const bool has_next = S.next(ui + 1, nxt);
        const char* nA = has_next ? (const char*)g.A + (size_t)nxt.pm * tstep : cA; const char* nB = has_next ? (const char*)g.Bt + (size_t)nxt.pn * tstep : cB;
        for (int t = 0; t < nt; t += 2) {
            const bool last = (t == nt - 2);
            const char* a1 = cA + (size_t)(t + 1) * kstep;
            const char* a2 = last ? nA : cA + (size_t)(t + 2) * kstep; const char* b2 = last ? nB : cB + (size_t)(t + 2) * kstep;
            const char* a3 = a2 + kstep; const char* b3 = b2 + kstep;
            if (last && has_next) S.a_ready(nxt);
            if constexpr (SP2) {
            PG8_LDB(B0, 0, 0); PG8_LDB(B1, 0, 1); PG8_SCHED; PG8_LDA(At, 0, 0); PG8_STAGE(PG8_SA(1, 1), a1 + hstep, voffA);
            PG8_WAIT_V(8); PG8_WAIT_L(0); PG8_BAR; PG8_MMA(0, 0, At, B0); PG8_MMA(0, 1, At, B1); PG8_BAR; PG8_SCHED;
            PG8_LDA(At, 0, 1); PG8_STAGE(PG8_SB(0, 0), b2, voffB); PG8_STAGE(PG8_SB(0, 1), b2 + hstep, voffB); PG8_STAGE(PG8_SA(0, 0), a2, voffA);
            PG8_WAIT_V(8); PG8_WAIT_L(0); PG8_BAR; PG8_MMA(1, 0, At, B0); PG8_MMA(1, 1, At, B1); PG8_BAR; PG8_SCHED;
            PG8_LDB(B0, 1, 0); PG8_LDB(B1, 1, 1); PG8_SCHED; PG8_LDA(At, 1, 0); PG8_STAGE(PG8_SA(0, 1), a2 + hstep, voffA);
            PG8_WAIT_V(8); PG8_WAIT_L(0); PG8_BAR; PG8_MMA(0, 0, At, B0); PG8_MMA(0, 1, At, B1); PG8_BAR; PG8_SCHED;
            PG8_LDA(At, 1, 1); PG8_STAGE(PG8_SB(1, 0), b3, voffB); PG8_STAGE(PG8_SB(1, 1), b3 + hstep, voffB); PG8_STAGE(PG8_SA(1, 0), a3, voffA);
            PG8_WAIT_V(8); PG8_WAIT_L(0); PG8_BAR; PG8_MMA(1, 0, At, B0); PG8_MMA(1, 1, At, B1); PG8_BAR; PG8_SCHED;
            } else {
            PG8_LDB(B0, 0, 0); PG8_SCHED; PG8_LDA(At, 0, 0); PG8_STAGE(PG8_SA(1, 1), a1 + hstep, voffA);
            PG8_WAIT_L(8); PG8_BAR; PG8_WAIT_L(0); PG8_MMA(0, 0, At, B0); PG8_BAR; PG8_SCHED;
            PG8_LDB(B1, 0, 1); PG8_STAGE(PG8_SB(0, 0), b2, voffB);
            PG8_BAR; PG8_WAIT_L(0); PG8_MMA(0, 1, At, B1); PG8_BAR;
            PG8_LDA(At, 0, 1); PG8_STAGE(PG8_SA(0, 0), a2, voffA);
            PG8_BAR; PG8_WAIT_L(0); PG8_MMA(1, 0, At, B0); PG8_BAR; PG8_SCHED;
            PG8_STAGE(PG8_SB(0, 1), b2 + hstep, voffB);
            PG8_WAIT_V(6); PG8_BAR; PG8_MMA(1, 1, At, B1); PG8_BAR;
            PG8_LDB(B0, 1, 0); PG8_SCHED; PG8_LDA(At, 1, 0); PG8_STAGE(PG8_SA(0, 1), a2 + hstep, voffA);
            PG8_WAIT_L(8); PG8_BAR; PG8_WAIT_L(0); PG8_MMA(0, 0, At, B0); PG8_BAR; PG8_SCHED;
            PG8_LDB(B1, 1, 1); PG8_STAGE(PG8_SB(1, 0), b3, voffB);
            PG8_BAR; PG8_WAIT_L(0); PG8_MMA(0, 1, At, B1); PG8_BAR;
            PG8_LDA(At, 1, 1); PG8_STAGE(PG8_SA(1, 0), a3, voffA);
            PG8_BAR; PG8_WAIT_L(0); PG8_MMA(1, 0, At, B0); PG8_BAR; PG8_SCHED;
            PG8_STAGE(PG8_SB(1, 1), b3 + hstep, voffB);
            PG8_WAIT_V(6); PG8_BAR; PG8_MMA(1, 1, At, B1); PG8_BAR;
            }
        }
        if constexpr (ALIGN_EPI) { if (wr == 0) PG8_BAR; }
        if constexpr (!Epi::AFTER_DRAIN) { E(acc, cur, wr, wc, fr, fq); S.done(cur); }
        if (!has_next) break;
#pragma unroll
        for (int a = 0; a < 2; ++a)
#pragma unroll
            for (int b = 0; b < 2; ++b)
#pragma unroll
                for (int m = 0; m < 4; ++m)
#pragma unroll
                    for (int n = 0; n < 2; ++n) acc[a][b][m][n] = (f32x4){0.f, 0.f, 0.f, 0.f};
        cur = nxt; cA = nA; cB = nB; ++ui;
        if constexpr (ALIGN_EPI) { if (wr == 1) PG8_BAR; }
    }
    PG8_WAIT_V(0);
    if constexpr (!ALIGN_EPI) { if (wr == 0) PG8_BAR; }
    PG8_BAR;
    if constexpr (Epi::AFTER_DRAIN) { E.fused(acc, cur, wr, wc, fr, fq, lds, wid, lane); S.done(cur); }
#undef PG8_SA
#undef PG8_SB
#undef PG8_STAGE
#undef PG8_LDA
#undef PG8_LDB
#undef PG8_MMA
#undef PG8_WAIT_V
#undef PG8_WAIT_L
#undef PG8_BAR
#undef PG8_SCHED
}
}

#define XB_TMO      128
#define XB_XCNT(j)  (256  + 64 * (j))
#define XB_XSUB(j)  (1280 + 64 * (j))
#define XB_XGEN(j)  (2304 + 64 * (j))
#define XB_TOP      3328
#define XB_TOPGEN   3392
#define XCD_BAR_WORDS 3456
#define XB_SPIN_CAP (1u << 22)
__device__ __forceinline__ unsigned xb_ld(unsigned* p)              { return __hip_atomic_load(p, __ATOMIC_RELAXED, __HIP_MEMORY_SCOPE_AGENT); }
__device__ __forceinline__ unsigned xb_add(unsigned* p, unsigned v) { return __hip_atomic_fetch_add(p, v, __ATOMIC_RELAXED, __HIP_MEMORY_SCOPE_AGENT); }
__device__ __forceinline__ unsigned xb_xcc_id() { return (unsigned)__builtin_amdgcn_s_getreg((3 << 11) | 20) & 0xFu; }
#define XB_SPIN(cond, bar) do { unsigned _sp = 0; while (cond) { __builtin_amdgcn_s_sleep(1); \
    if ((++_sp & 255u) == 0u) { if (xb_ld(&(bar)[XB_TMO])) break; if (_sp > XB_SPIN_CAP) { atomicAdd(&(bar)[XB_TMO], 1u); break; } } } } while (0)
struct XcdBarrier { unsigned* bar; unsigned x; volatile LAS unsigned* st; };
__device__ __forceinline__ XcdBarrier xcd_barrier_post(unsigned* bar, volatile LAS unsigned* st) {
    XcdBarrier b; b.bar = bar; b.x = xb_xcc_id(); b.st = st;
    if (threadIdx.x == 0) (void)xb_add(&bar[XB_XCNT(b.x)], 1u);
    return b;
}
__device__ __forceinline__ void xcd_barrier_complete(unsigned* bar, unsigned x, unsigned& nloc, unsigned& nx) {
    const unsigned G = gridDim.x * gridDim.y * gridDim.z;
    unsigned sum, cnt, mine, sp = 0u;
    for (;;) {
        sum = 0u; cnt = 0u; mine = 0u;
#pragma unroll
        for (unsigned j = 0; j < 16; ++j) { const unsigned c = xb_ld(&bar[XB_XCNT(j)]); sum += c; cnt += (c > 0u) ? 1u : 0u; mine = (j == x) ? c : mine; }
        if (sum == G) break;
        __builtin_amdgcn_s_sleep(1);
        if ((++sp & 255u) == 0u) { if (xb_ld(&bar[XB_TMO])) break; if (sp > XB_SPIN_CAP) { atomicAdd(&bar[XB_TMO], 1u); break; } }
    }
    nloc = mine > 0u ? mine : 1u; nx = cnt > 0u ? cnt : 1u;
}
__device__ __forceinline__ void xcd_barrier(const XcdBarrier& b) {
    asm volatile("s_waitcnt vmcnt(0)" ::: "memory");
    __syncthreads();
    if (threadIdx.x == 0) {
        unsigned* bar = b.bar;
        __builtin_amdgcn_s_waitcnt(0);
        unsigned nloc = b.st[0], nx = b.st[1];
        if (nloc == 0u) { xcd_barrier_complete(bar, b.x, nloc, nx); b.st[0] = nloc; b.st[1] = nx; }
        const unsigned old = xb_add(&bar[XB_XSUB(b.x)], 1u);
        const unsigned gen = old / nloc;
        if (old + 1u == (gen + 1u) * nloc) {
            __builtin_amdgcn_fence(__ATOMIC_RELEASE, "agent");
            asm volatile("s_waitcnt vmcnt(0)" ::: "memory");
            const unsigned og = xb_add(&bar[XB_TOP], 1u);
            const unsigned tg = og / nx;
            if (og + 1u == (tg + 1u) * nx) xb_add(&bar[XB_TOPGEN], 1u);
            else XB_SPIN(xb_ld(&bar[XB_TOPGEN]) == tg, bar);
            __builtin_amdgcn_fence(__ATOMIC_ACQUIRE, "agent");
            xb_add(&bar[XB_XGEN(b.x)], 1u);
            asm volatile("s_waitcnt vmcnt(0)" ::: "memory");
        } else {
            XB_SPIN(xb_ld(&bar[XB_XGEN(b.x)]) == gen, bar);
            __builtin_amdgcn_fence(__ATOMIC_ACQUIRE, "agent");
            asm volatile("s_waitcnt vmcnt(0)" ::: "memory");
        }
    }
    __syncthreads();
}

constexpr int NWAVES = 8, NTHR = NWAVES * 64;
constexpr int RING_BYTES = 131072, MISC_OFF = RING_BYTES, AUX_OFF = MISC_OFF + 256, LDS_BYTES = 147456;
constexpr size_t WS_MODP = WS_MOD + 64 * 1024;
constexpr int CW_BAR = 1024;
constexpr int MAX_LAUNCH = 8;
constexpr size_t CTL_ZERO_BYTES = (size_t)(CW_BAR + MAX_LAUNCH * XCD_BAR_WORDS) * 4;
#define LDS_WAIT() asm volatile("s_waitcnt lgkmcnt(0)" ::: "memory")

struct Args { const float* in[20]; float* out; unsigned char* ws; int ph_lo, ph_hi, li, pad; };
enum { I_X = 0, I_C, I_WADA, I_BADA, I_N1PRE, I_N1POST, I_WIN, I_CONVW, I_CONVB, I_DTB, I_ALOG, I_DSKIP, I_SSMN, I_RELB, I_ATTN, I_WOUT, I_N2PRE, I_N2POST, I_W1, I_W2 };

template <int MODE> __device__ __forceinline__ void p0_transpose_item(const float* W, int K, int N, h16* WT, LAS float* scr, int item, int nblk, int lane) {
    const int kb = item / nblk, nb = item % nblk, k0 = 64 * kb, n0 = 32 * nb;
    const int sc = MODE ? win_src(n0 + (lane & 31)) : n0 + (lane & 31);
#pragma unroll 8
    for (int i = 0; i < 32; ++i) { const int kk = 2 * i + (lane >> 5); scr[kk * 33 + (lane & 31)] = sc >= 0 ? W[(size_t)(k0 + kk) * N + sc] : 0.f; }
    LDS_WAIT(); asm volatile("" ::: "memory");
    const int c = lane & 7;
#pragma unroll
    for (int j = 0; j < 4; ++j) { const int n = (lane >> 3) + 8 * j; const LAS float* s = scr + (8 * c) * 33 + n;
        u32x4 o; o.x = pk_h2(s[0 * 33], s[1 * 33]); o.y = pk_h2(s[2 * 33], s[3 * 33]); o.z = pk_h2(s[4 * 33], s[5 * 33]); o.w = pk_h2(s[6 * 33], s[7 * 33]);
        *(u32x4*)(WT + (size_t)(n0 + n) * K + k0 + 8 * c) = o; }
    LDS_WAIT(); asm volatile("" ::: "memory");
}

__global__ void __launch_bounds__(NTHR, 2) mk_fwd(Args args) {
    extern __shared__ __attribute__((aligned(16))) unsigned char lds_raw[];
    LAS unsigned char* lds = (LAS unsigned char*)lds_raw;
    volatile LAS unsigned* MISC = (volatile LAS unsigned*)(lds + MISC_OFF);
    const int tid = threadIdx.x, lane = tid & 63, wave = __builtin_amdgcn_readfirstlane(tid >> 6);
    const int G = gridDim.x, bx = blockIdx.x, gw = bx * NWAVES + wave, NGW = G * NWAVES;
    unsigned char* ws = args.ws;
    unsigned* ctl = (unsigned*)(ws + WS_CTL);
    const float* x = args.in[I_X]; float* out = args.out;
    float* MOD = (float*)(ws + WS_MOD); float* MODP = (float*)(ws + WS_MODP); float* PF32 = (float*)(ws + WS_PF32);
    h16* WIN = (h16*)(ws + WS_WIN); h16* WOUT = (h16*)(ws + WS_WOUT); h16* W1 = (h16*)(ws + WS_W1); h16* W2 = (h16*)(ws + WS_W2);
    h16* XN = (h16*)(ws + WS_XN); h16* PROJ = (h16*)(ws + WS_PROJ); h16* MIX = (h16*)(ws + WS_MIX);
    float* MIXO = (float*)(ws + WS_MIXO); h16* HB = (h16*)(ws + WS_H); float* FB = (float*)(ws + WS_F);
    if (tid < 64) MISC[tid] = 0u;
    __syncthreads();
    XcdBarrier bar = xcd_barrier_post(ctl + CW_BAR + args.li * XCD_BAR_WORDS, MISC + 8);
    const int lo = args.ph_lo, hi = args.ph_hi;
#define IN(k) (lo <= (k) && (k) < hi)
#define SEAM(k) do { if (IN(k) && IN((k) + 1)) xcd_barrier(bar); } while (0)

    if (IN(0)) {
        LAS float* scr = (LAS float*)(lds + wave * 16384);
        constexpr int I_IN = 16 * 96, I_O = 16 * 32, I_1 = 16 * 128, I_2 = 64 * 32, I_M = 96 * 16, NITEMS = I_IN + I_O + I_1 + I_2 + I_M;
        for (int it = gw; it < NITEMS; it += NGW) {
            int r = it;
            if (r < I_IN) { p0_transpose_item<1>(args.in[I_WIN], D, 2896, WIN, scr, r, 96, lane); continue; } r -= I_IN;
            if (r < I_O) { p0_transpose_item<0>(args.in[I_WOUT], D, D, WOUT, scr, r, 32, lane); continue; } r -= I_O;
            if (r < I_1) { p0_transpose_item<0>(args.in[I_W1], D, FF, W1, scr, r, 128, lane); continue; } r -= I_1;
            if (r < I_2) { p0_transpose_item<0>(args.in[I_W2], FF, D, W2, scr, r, 32, lane); continue; } r -= I_2;
            const int cg = r % 96, ks = r / 96, jj = cg * 64 + lane, k0 = ks * 64;
            const float s0 = silu_f(args.in[I_C][k0 + lane]), s1 = silu_f(args.in[I_C][D + k0 + lane]);
            const float* wp = args.in[I_WADA] + (size_t)k0 * (6 * D) + jj; float a0 = 0.f, a1 = 0.f;
#pragma unroll 16
            for (int kk = 0; kk < 64; ++kk) { const float w = wp[(size_t)kk * (6 * D)]; a0 += __shfl(s0, kk) * w; a1 += __shfl(s1, kk) * w; }
            MODP[(size_t)(ks * 2 + 0) * (6 * D) + jj] = a0; MODP[(size_t)(ks * 2 + 1) * (6 * D) + jj] = a1;
        }
    }
    SEAM(0);
    if (IN(1)) {
        for (int i = bx * NTHR + tid; i < NB * 6 * D; i += G * NTHR) { const int b = i / (6 * D), jj = i % (6 * D); float a = args.in[I_BADA][jj];
#pragma unroll
            for (int ks = 0; ks < 16; ++ks) a += MODP[(size_t)(ks * 2 + b) * (6 * D) + jj];
            MOD[i] = a; }
        LAS float* mv = (LAS float*)lds;
        for (int i = tid; i < NB * 2 * D; i += NTHR) { const int b = i / (2 * D), jj = i % (2 * D); float a = args.in[I_BADA][jj];
#pragma unroll
            for (int ks = 0; ks < 16; ++ks) a += MODP[(size_t)(ks * 2 + b) * (6 * D) + jj];
            mv[i] = a; }
        __syncthreads();
        const float* g1 = args.in[I_N1PRE];
        for (int m = gw; m < M; m += NGW) {
            const int b = m / T; const f32x4* xr = (const f32x4*)(x + (size_t)m * D) + lane; f32x4 v[4]; float ss = 0.f;
#pragma unroll
            for (int j = 0; j < 4; ++j) { v[j] = xr[64 * j]; ss += (v[j].x * v[j].x + v[j].y * v[j].y) + (v[j].z * v[j].z + v[j].w * v[j].w); }
            const float rstd = rsqrtf(wave_sum(ss) * (1.f / D) + EPS);
            u32x2* o8 = (u32x2*)(XN + (size_t)m * D) + lane;
#pragma unroll
            for (int j = 0; j < 4; ++j) { const int k = 4 * lane + 256 * j; const f32x4 gg = *(const f32x4*)(g1 + k);
                const f32x4 sh = *(const LAS f32x4*)(mv + b * 2 * D + k), sc = *(const LAS f32x4*)(mv + b * 2 * D + D + k);
                const f32x4 r = v[j] * rstd * gg * (sc + 1.f) + sh; u32x2 w; w.x = pk_h2(r.x, r.y); w.y = pk_h2(r.z, r.w); o8[64 * j] = w; }
        }
        __syncthreads();
    }
    SEAM(1);
    if (IN(2)) {
        pg8::Gemm g{XN, WIN, M, NPROJ, D}; pg8::StaticOrder S; S.init(M, NPROJ, G, bx);
        pg8::EpiH16<0, true> E{PROJ, NPROJ, PF32};
        pg8::gemm_phase<pg8::EpiH16<0, true>, pg8::StaticOrder, true, true>(lds, g, S, E);
    }
    SEAM(2);
    if (IN(3)) {
        LAS h16* raw = (LAS h16*)(lds + wave * 16384);
        constexpr int N_CONV = NB * 128 * 16, N_SCAN = NB * 32 * 8;
        for (int it = gw; it < N_CONV + N_SCAN; it += NGW) {
            if (it < N_CONV) {
                const int cb = it & 15, tb = (it >> 4) & 127, b = it >> 11, t0 = tb * 64; const size_t m0 = (size_t)b * T + t0;
#pragma unroll
                for (int i = 0; i < 9; ++i) { const int row = (lane >> 3) + 8 * i, ch = lane & 7; u32x4 v = {0u, 0u, 0u, 0u};
                    if (row < 67 && t0 - 3 + row >= 0) v = *(const u32x4*)(PROJ + (m0 - 3 + row) * NPROJ + C_XBC + cb * 64 + ch * 8);
                    *(LAS u32x4*)(raw + row * 64 + ch * 8) = v; }
                LDS_WAIT(); asm volatile("" ::: "memory");
                const int chn = cb * 64 + lane;
                const float w0 = args.in[I_CONVW][chn], w1 = args.in[I_CONVW][1024 + chn], w2 = args.in[I_CONVW][2048 + chn], w3 = args.in[I_CONVW][3072 + chn], cbias = args.in[I_CONVB][chn];
                float r0 = (float)raw[lane], r1 = (float)raw[64 + lane], r2 = (float)raw[128 + lane];
                unsigned yp[32];
#pragma unroll
                for (int t = 0; t < 64; t += 2) {
                    const float r3 = (float)raw[(t + 3) * 64 + lane], r4 = (float)raw[(t + 4) * 64 + lane];
                    const float a0 = cbias + w0 * r0 + w1 * r1 + w2 * r2 + w3 * r3, a1 = cbias + w0 * r1 + w1 * r2 + w2 * r3 + w3 * r4;
                    const float y0 = a0 * __builtin_amdgcn_rcpf(1.f + __expf(-a0)), y1 = a1 * __builtin_amdgcn_rcpf(1.f + __expf(-a1));
                    yp[t >> 1] = pk_h2(y0, y1);
                    raw[t * 64 + lane] = (h16)y0; raw[(t + 1) * 64 + lane] = (h16)y1;
                    r0 = r2; r1 = r3; r2 = r4;
                }
                LDS_WAIT(); asm volatile("" ::: "memory");
                h16* xc = (h16*)((unsigned char*)out + DO_XC);
#pragma unroll
                for (int i = 0; i < 8; ++i) { const int row = (lane >> 3) + 8 * i, ch = lane & 7;
                    *(u32x4*)(xc + (m0 + row) * 1024 + cb * 64 + ch * 8) = *(const LAS u32x4*)(raw + row * 64 + ch * 8); }
                if (cb < 12) {
                    h16* dst = cb < 8 ? (h16*)((unsigned char*)out + DO_XST) + ((size_t)(b * 8 + cb) * 64 + lane) * T + t0
                                      : (h16*)((unsigned char*)out + DO_BT) + ((size_t)(b * 2 + ((cb - 8) >> 1)) * 128 + ((cb - 8) & 1) * 64 + lane) * T + t0;
#pragma unroll
                    for (int i = 0; i < 8; ++i) { u32x4 v = {yp[4 * i], yp[4 * i + 1], yp[4 * i + 2], yp[4 * i + 3]}; *(u32x4*)(dst + 8 * i) = v; }
                }
                LDS_WAIT(); asm volatile("" ::: "memory");
            } else {
                const int r = it - N_CONV, h = r & 7, c = (r >> 3) & 31, b = r >> 8; const size_t m = (size_t)b * T + c * 256 + 4 * lane;
                const float a = -__expf(args.in[I_ALOG][h]), bias = args.in[I_DTB][h];
                f32x4 dt, cs; float run = 0.f;
#pragma unroll
                for (int j = 0; j < 4; ++j) { dt[j] = softplus_f(PF32[(m + j) * 16 + h] + bias); run += a * dt[j]; cs[j] = run; }
                float incl = run;
#pragma unroll
                for (int o = 1; o < 64; o <<= 1) { const float u = __shfl_up(incl, o); if (lane >= o) incl += u; }
                const float excl = incl - run;
                float* DTp = (float*)(ws + WS_DT); float* ACSp = (float*)(ws + WS_ACS); const size_t o4 = (size_t)(b * 8 + h) * T + c * 256 + 4 * lane;
                *(f32x4*)(DTp + o4) = dt; *(f32x4*)(ACSp + o4) = cs + excl;
            }
        }
    }
    SEAM(3);
    if (IN(4)) {
        LAS float* wtab = (LAS float*)lds;
        const h16* XST = (const h16*)((unsigned char*)out + DO_XST); const h16* BT = (const h16*)((unsigned char*)out + DO_BT);
        const float* DTp = (const float*)(ws + WS_DT); const float* ACSp = (const float*)(ws + WS_ACS); float* ST = (float*)(ws + WS_STATES);
        const int r = lane & 31, hh = lane >> 5, pt = wave & 1, ntile = wave >> 1;
        for (int u = bx; u < NB * 32 * 8; u += G) {
            const int h = u & 7, c = (u >> 3) & 31, b = u >> 8, g = h >> 2; const size_t tb = (size_t)(b * 8 + h) * T + c * 256;
            if (tid < 256) wtab[tid] = DTp[tb + tid] * __expf(ACSp[tb + 255] - ACSp[tb + tid]);
            __syncthreads();
            f32x16 acc;
#pragma unroll
            for (int i = 0; i < 16; ++i) acc[i] = 0.f;
            const h16* ap = XST + ((size_t)(b * 8 + h) * 64 + pt * 32 + r) * T + c * 256 + 8 * hh;
            const h16* bp = BT + ((size_t)(b * 2 + g) * 128 + ntile * 32 + r) * T + c * 256 + 8 * hh;
#pragma unroll 4
            for (int ks = 0; ks < 16; ++ks) {
                const h16x8 A = *(const h16x8*)(ap + 16 * ks), Bv = *(const h16x8*)(bp + 16 * ks);
                const f32x4 wa = *(const LAS f32x4*)(wtab + 16 * ks + 8 * hh), wb = *(const LAS f32x4*)(wtab + 16 * ks + 8 * hh + 4);
                h16x8 Bs;
#pragma unroll
                for (int j = 0; j < 4; ++j) { Bs[j] = (h16)((float)Bv[j] * wa[j]); Bs[4 + j] = (h16)((float)Bv[4 + j] * wb[j]); }
                acc = __builtin_amdgcn_mfma_f32_32x32x16_f16(A, Bs, acc, 0, 0, 0);
            }
            float* sp = ST + ((size_t)((b * 32 + c) * 8 + h) * 64 + pt * 32) * 128 + ntile * 32 + r;
#pragma unroll
            for (int i = 0; i < 16; ++i) sp[(size_t)((i & 3) + 8 * (i >> 2) + 4 * hh) * 128] = acc[i];
            __syncthreads();
        }
    }
    SEAM(4);
    if (IN(5)) {
        const float* ACSp = (const float*)(ws + WS_ACS); const float* ST = (const float*)(ws + WS_STATES); h16* PV = (h16*)(ws + WS_PREV);
        for (int e = bx * NTHR + tid; e < NB * 8 * 64 * 128; e += G * NTHR) {
            const int pn = e & 8191, h = (e >> 13) & 7, b = e >> 16; float hs = 0.f;
            float sv[32];
#pragma unroll
            for (int c = 0; c < 32; ++c) sv[c] = ST[(size_t)((b * 32 + c) * 8 + h) * 8192 + pn];
#pragma unroll
            for (int c = 0; c < 32; ++c) { PV[(size_t)((b * 32 + c) * 8 + h) * 8192 + pn] = (h16)hs; hs = hs * __expf(ACSp[(size_t)(b * 8 + h) * T + c * 256 + 255]) + sv[c]; }
        }
    }
    SEAM(5);
    if (IN(6)) {
        LAS float* acs_tab = (LAS float*)lds; LAS float* dt_tab = acs_tab + 2048; LAS float* part = dt_tab + 2048;
        const h16* XC = (const h16*)((unsigned char*)out + DO_XC); const h16* XST = (const h16*)((unsigned char*)out + DO_XST);
        const float* DTp = (const float*)(ws + WS_DT); const float* ACSp = (const float*)(ws + WS_ACS); const h16* PV = (const h16*)(ws + WS_PREV);
        const int r = lane & 31, hh = lane >> 5, h = wave, g = h >> 2; const float dsk = args.in[I_DSKIP][h];
        for (int i = 0;; ++i) {
            const int j = i * G + bx; if (j >= NB * 32 * 8) break;
            const int bc = j >> 3, lbr = j & 7, lb = (i & 1) ? 7 - lbr : lbr, b = bc >> 5, c = bc & 31, t0 = c * 256;
            for (int k = tid; k < 2048; k += NTHR) { const size_t o = (size_t)(b * 8 + (k >> 8)) * T + t0 + (k & 255); acs_tab[k] = ACSp[o]; dt_tab[k] = DTp[o]; }
            __syncthreads();
            const int l = lb * 32 + r; const size_t ml = (size_t)b * T + t0 + l; const float acs_l = acs_tab[h * 256 + l];
            h16x8 Cf[8];
#pragma unroll
            for (int ks = 0; ks < 8; ++ks) Cf[ks] = *(const h16x8*)(XC + ml * 1024 + 768 + g * 128 + 16 * ks + 8 * hh);
            f32x16 Y[2];
#pragma unroll
            for (int q = 0; q < 16; ++q) { Y[0][q] = 0.f; Y[1][q] = 0.f; }
            const h16* xst = XST + ((size_t)(b * 8 + h) * 64 + r) * T + t0 + 4 * hh;
            for (int sb = 0; sb <= lb; ++sb) {
                const size_t ms = (size_t)b * T + t0 + sb * 32 + r;
                f32x16 Dv;
#pragma unroll
                for (int q = 0; q < 16; ++q) Dv[q] = 0.f;
#pragma unroll
                for (int ks = 0; ks < 8; ++ks) { const h16x8 Bf = *(const h16x8*)(XC + ms * 1024 + 512 + g * 128 + 16 * ks + 8 * hh); Dv = __builtin_amdgcn_mfma_f32_32x32x16_f16(Bf, Cf[ks], Dv, 0, 0, 0); }
                h16x8 Mf[2];
#pragma unroll
                for (int q = 0; q < 4; ++q) { const int sl = sb * 32 + 8 * q + 4 * hh;
                    const f32x4 as = *(const LAS f32x4*)(acs_tab + h * 256 + sl), ds = *(const LAS f32x4*)(dt_tab + h * 256 + sl);
#pragma unroll
                    for (int e = 0; e < 4; ++e) { float v = Dv[4 * q + e] * __expf(acs_l - as[e]) * ds[e]; if (sl + e > l) v = 0.f; Mf[q >> 1][(q & 1) * 4 + e] = (h16)v; } }
#pragma unroll
                for (int s2 = 0; s2 < 2; ++s2)
#pragma unroll
                    for (int pt = 0; pt < 2; ++pt) { const h16* ap = xst + (size_t)(pt * 32) * T + sb * 32 + 16 * s2;
                        const h16x4 lo = *(const h16x4*)ap, hi = *(const h16x4*)(ap + 8);
                        const h16x8 A = {lo[0], lo[1], lo[2], lo[3], hi[0], hi[1], hi[2], hi[3]};
                        Y[pt] = __builtin_amdgcn_mfma_f32_32x32x16_f16(A, Mf[s2], Y[pt], 0, 0, 0); }
            }
            {
                f32x16 O[2];
#pragma unroll
                for (int q = 0; q < 16; ++q) { O[0][q] = 0.f; O[1][q] = 0.f; }
                const h16* pv = PV + ((size_t)((b * 32 + c) * 8 + h) * 64 + r) * 128 + 8 * hh;
#pragma unroll
                for (int ks = 0; ks < 8; ++ks)
#pragma unroll
                    for (int pt = 0; pt < 2; ++pt) { const h16x8 A = *(const h16x8*)(pv + (size_t)(pt * 32) * 128 + 16 * ks); O[pt] = __builtin_amdgcn_mfma_f32_32x32x16_f16(A, Cf[ks], O[pt], 0, 0, 0); }
                const float el = __expf(acs_l);
#pragma unroll
                for (int q = 0; q < 16; ++q) { Y[0][q] += O[0][q] * el; Y[1][q] += O[1][q] * el; }
            }
            float ss = 0.f;
#pragma unroll
            for (int pt = 0; pt < 2; ++pt)
#pragma unroll
                for (int q = 0; q < 4; ++q) { const int p0 = h * 64 + pt * 32 + 8 * q + 4 * hh;
                    const h16x4 xv = *(const h16x4*)(XC + ml * 1024 + p0), zv = *(const h16x4*)(PROJ + ml * NPROJ + C_Z + p0);
#pragma unroll
                    for (int e = 0; e < 4; ++e) { const float z = (float)zv[e]; const float u = (Y[pt][4 * q + e] + dsk * (float)xv[e]) * (z * __builtin_amdgcn_rcpf(1.f + __expf(-z))); Y[pt][4 * q + e] = u; ss += u * u; } }
            ss += __shfl_xor(ss, 32);
            if (hh == 0) part[h * 32 + r] = ss;
            __syncthreads();
            float tot = 0.f;
#pragma unroll
            for (int w = 0; w < 8; ++w) tot += part[w * 32 + r];
            const float rstd = rsqrtf(tot * (1.f / 512.f) + EPS);
#pragma unroll
            for (int pt = 0; pt < 2; ++pt)
#pragma unroll
                for (int q = 0; q < 4; ++q) { const int p0 = h * 64 + pt * 32 + 8 * q + 4 * hh; const f32x4 wv = *(const f32x4*)(args.in[I_SSMN] + p0);
                    u32x2 o; o.x = pk_h2(Y[pt][4 * q] * rstd * wv[0], Y[pt][4 * q + 1] * rstd * wv[1]); o.y = pk_h2(Y[pt][4 * q + 2] * rstd * wv[2], Y[pt][4 * q + 3] * rstd * wv[3]);
                    *(u32x2*)(MIX + ml * D + p0) = o; }
            __syncthreads();
        }
    }
    SEAM(6);
    if (IN(7)) {
        float* slab = (float*)((unsigned char*)out + (size_t)bx * (8 * T * 4));
        LAS unsigned* hist = (LAS unsigned*)(lds + wave * 8448);
        unsigned short* IDX = (unsigned short*)(ws + WS_IDX);
        const int r = lane & 31, hh = lane >> 5;
        for (int i = 0;; ++i) {
            const int rho = i * G + ((i & 1) ? G - 1 - bx : bx); if (rho >= NB * (T / 8)) break;
            const int b = rho & 1, tq0 = 8 * (T / 8 - 1 - (rho >> 1));
            const size_t mq0 = (size_t)b * T + tq0;
            const int tq = tq0 + wave, n = tq + 1;
            unsigned short* orow = IDX + (mq0 + wave) * TOPK;
            if (tq0 + 8 <= TOPK) {
#pragma unroll
                for (int e = 0; e < 4; ++e) { const int j = 4 * lane + e; orow[j] = (unsigned short)(j < n ? j : 0); }
                continue;
            }
            {
                h16x8 Af[2][4]; float wq[2][2][8];
#pragma unroll
                for (int tl = 0; tl < 2; ++tl) {
                    const int hd = (r & 3) + 4 * ((r >> 3) & 1), ql = 4 * tl + ((r >> 2) & 1) + 2 * (r >> 4);
#pragma unroll
                    for (int ks = 0; ks < 4; ++ks) Af[tl][ks] = *(const h16x8*)(PROJ + (mq0 + ql) * NPROJ + C_QI + hd * 64 + 16 * ks + 8 * hh);
#pragma unroll
                    for (int hf = 0; hf < 2; ++hf) { const float* wp = PF32 + (mq0 + 4 * tl + hh + 2 * hf) * 16 + 8;
#pragma unroll
                        for (int e = 0; e < 8; ++e) wq[tl][hf][e] = wp[e] * (0.35355339059327373f * 0.125f); }
                }
                const int ntile = (tq0 + 8 + 31) >> 5;
                for (int kt = wave; kt < ntile; kt += NWAVES) {
                    const h16* kp = PROJ + ((size_t)b * T + kt * 32 + r) * NPROJ + C_KI + 8 * hh;
                    h16x8 Bf[4];
#pragma unroll
                    for (int ks = 0; ks < 4; ++ks) Bf[ks] = *(const h16x8*)(kp + 16 * ks);
#pragma unroll
                    for (int tl = 0; tl < 2; ++tl) {
                        f32x16 Dv;
#pragma unroll
                        for (int q = 0; q < 16; ++q) Dv[q] = 0.f;
#pragma unroll
                        for (int ks = 0; ks < 4; ++ks) Dv = __builtin_amdgcn_mfma_f32_32x32x16_f16(Af[tl][ks], Bf[ks], Dv, 0, 0, 0);
#pragma unroll
                        for (int hf = 0; hf < 2; ++hf) { float sc = 0.f;
#pragma unroll
                            for (int e = 0; e < 8; ++e) sc += wq[tl][hf][e] * fmaxf(Dv[8 * hf + e], 0.f);
                            slab[(size_t)(4 * tl + hh + 2 * hf) * T + kt * 32 + r] = sc; }
                    }
                }
            }
            asm volatile("s_waitcnt vmcnt(0)" ::: "memory");
            __syncthreads();
            __builtin_amdgcn_fence(__ATOMIC_ACQUIRE, "agent");
            asm volatile("s_waitcnt vmcnt(0)" ::: "memory");
            {
                const float* row = slab + (size_t)wave * T;
                unsigned prefix = 0u, pmask = 0u; int need = TOPK;
#pragma unroll 1
                for (int lvl = 0; lvl < 3; ++lvl) {
                    const int sh = lvl == 0 ? 21 : (lvl == 1 ? 10 : 0); const unsigned bm = lvl == 2 ? 0x3ffu : 0x7ffu;
                    for (int k = lane; k < 2112; k += 64) hist[k] = 0u;
                    LDS_WAIT(); asm volatile("" ::: "memory");
                    for (int i0 = 0; i0 < n; i0 += 256) {
                        const f32x4 v = *(const f32x4*)(row + i0 + 4 * lane);
#pragma unroll
                        for (int e = 0; e < 4; ++e) { const unsigned key = fkey(v[e]); const unsigned bin = (key >> sh) & bm;
                            if (i0 + 4 * lane + e < n && (key & pmask) == prefix) __hip_atomic_fetch_add(&hist[bin + (bin >> 5)], 1u, __ATOMIC_RELAXED, __HIP_MEMORY_SCOPE_WORKGROUP); }
                    }
                    LDS_WAIT(); asm volatile("" ::: "memory");
                    unsigned own = 0u;
#pragma unroll
                    for (int k = 0; k < 32; ++k) own += hist[33 * lane + k];
                    unsigned suf = own;
#pragma unroll
                    for (int o = 1; o < 64; o <<= 1) { const unsigned u = __shfl_down(suf, o); if (lane + o < 64) suf += u; }
                    const unsigned long long mk = __ballot(suf >= (unsigned)need);
                    const int Ls = 63 - __builtin_clzll(mk);
                    unsigned cum = suf - own; int Bsel = 0; unsigned above = 0u; bool found = false;
#pragma unroll
                    for (int k = 31; k >= 0; --k) { const unsigned c = hist[33 * lane + k]; if (!found && cum + c >= (unsigned)need) { found = true; Bsel = k; above = cum; } cum += c; }
                    const int Bl = __shfl(Bsel, Ls); const unsigned ab = __shfl(above, Ls);
                    const unsigned bin = (unsigned)(32 * Ls + Bl);
                    prefix |= bin << sh; pmask |= bm << sh; need -= (int)ab;
                }
                const unsigned Kt = prefix; unsigned base_gt = 0u, base_tie = 0u;
                for (int i0 = 0; i0 < n; i0 += 256) {
                    const f32x4 v = *(const f32x4*)(row + i0 + 4 * lane);
                    unsigned kk[4]; unsigned cg = 0u, ct = 0u;
#pragma unroll
                    for (int e = 0; e < 4; ++e) { kk[e] = (i0 + 4 * lane + e < n) ? fkey(v[e]) : 0u; cg += (kk[e] > Kt); ct += (kk[e] == Kt); }
                    unsigned pk = (ct << 16) | cg, inc = pk;
#pragma unroll
                    for (int o = 1; o < 64; o <<= 1) { const unsigned u = __shfl_up(inc, o); if (lane >= o) inc += u; }
                    const unsigned exc = inc - pk, tot = __shfl(inc, 63);
                    unsigned gt_before = base_gt + (exc & 0xffffu), tie_before = base_tie + (exc >> 16);
                    unsigned pos = gt_before + (tie_before < (unsigned)need ? tie_before : (unsigned)need);
#pragma unroll
                    for (int e = 0; e < 4; ++e) { bool s = kk[e] > Kt; if (kk[e] == Kt) { s = tie_before < (unsigned)need; ++tie_before; }
                        if (s) { orow[pos] = (unsigned short)(i0 + 4 * lane + e); ++pos; } }
                    base_gt += tot & 0xffffu; base_tie += tot >> 16;
                }
            }
            __syncthreads();
        }
    }
    SEAM(7);
    if (IN(8)) {
        constexpr int P_ROW = 528, V_ROW = 272, WSZ = 8 * P_ROW + 32 * V_ROW + 512;
        LAS unsigned char* wl = lds + wave * WSZ;
        LAS unsigned char* Pl = wl; LAS unsigned char* Vl = wl + 8 * P_ROW; LAS unsigned short* idxl = (LAS unsigned short*)(wl + 8 * P_ROW + 32 * V_ROW);
        LAS float* bias_tab = (LAS float*)(lds + NWAVES * WSZ); LAS unsigned char* zrow = lds + NWAVES * WSZ + 4096;
        const unsigned short* IDX = (const unsigned short*)(ws + WS_IDX);
        for (int k = tid; k < 1024; k += NTHR) bias_tab[k] = args.in[I_RELB][t5_bucket(k >> 3) * 8 + (k & 7)];
        for (int k = tid; k < P_ROW / 4; k += NTHR) ((LAS unsigned*)zrow)[k] = 0u;
        __syncthreads();
        const int kq = lane >> 4, l16 = lane & 15, hd = l16 & 7;
        const LAS unsigned char* prow = l16 < 8 ? Pl + l16 * P_ROW : zrow;
        for (int m = gw; m < M; m += NGW) {
            const int b = m / T, t = m % T, cnt = (t + 1 < TOPK) ? t + 1 : TOPK;
            *(LAS u32x2*)(idxl + 4 * lane) = *(const u32x2*)(IDX + (size_t)m * TOPK + 4 * lane);
            h16x8 Qf[4];
#pragma unroll
            for (int ks = 0; ks < 4; ++ks) {
                h16x8 q = *(const h16x8*)(PROJ + (size_t)m * NPROJ + C_Q + hd * 64 + 32 * (ks & 1) + 8 * kq);
                const bool ok = l16 < 8 && (l16 >> 2) == (ks >> 1);
#pragma unroll
                for (int j = 0; j < 8; ++j) Qf[ks][j] = ok ? q[j] * (h16)0.125f : (h16)0.f;
            }
            LDS_WAIT(); asm volatile("" ::: "memory");
            const h16* kvb = PROJ + (size_t)b * T * NPROJ;
            f32x4 S[16];
#pragma unroll
            for (int kt = 0; kt < 16; ++kt) {
                const int s = idxl[16 * kt + l16]; const h16* kp = kvb + (size_t)s * NPROJ + C_K + 8 * kq;
                f32x4 a = {0.f, 0.f, 0.f, 0.f};
#pragma unroll
                for (int ks = 0; ks < 4; ++ks) a = __builtin_amdgcn_mfma_f32_16x16x32_f16(*(const h16x8*)(kp + 32 * ks), Qf[ks], a, 0, 0, 0);
                S[kt] = a;
            }
            float mx = -1e30f;
#pragma unroll
            for (int kt = 0; kt < 16; ++kt) {
                const u32x2 iv = *(const LAS u32x2*)(idxl + 16 * kt + 4 * kq);
#pragma unroll
                for (int i = 0; i < 4; ++i) { const int s = (int)((i & 2 ? iv.y : iv.x) >> (16 * (i & 1))) & 0xffff; int dd = t - s; dd = dd < 0 ? 0 : (dd > 127 ? 127 : dd);
                    float lg = S[kt][i] + bias_tab[dd * 8 + hd]; if (16 * kt + 4 * kq + i >= cnt) lg = -1e30f; S[kt][i] = lg; mx = fmaxf(mx, lg); }
            }
            mx = fmaxf(mx, __shfl_xor(mx, 16)); mx = fmaxf(mx, __shfl_xor(mx, 32));
            float lsum = 0.f;
#pragma unroll
            for (int kt = 0; kt < 16; ++kt) {
                float p[4];
#pragma unroll
                for (int i = 0; i < 4; ++i) { p[i] = __expf(S[kt][i] - mx); lsum += p[i]; }
                if (l16 < 8) { u32x2 w; w.x = pk_h2(p[0], p[1]); w.y = pk_h2(p[2], p[3]); *(LAS u32x2*)(Pl + l16 * P_ROW + (16 * kt + 4 * kq) * 2) = w; }
            }
            lsum += __shfl_xor(lsum, 16); lsum += __shfl_xor(lsum, 32);
            f32x4 O[2][4];
#pragma unroll
            for (int g = 0; g < 2; ++g)
#pragma unroll
                for (int nt = 0; nt < 4; ++nt) O[g][nt] = (f32x4){0.f, 0.f, 0.f, 0.f};
            u32x4 vr[8];
#pragma unroll
            for (int i = 0; i < 8; ++i) { const int s = idxl[kq + 4 * i]; vr[i] = *(const u32x4*)(kvb + (size_t)s * NPROJ + C_V + l16 * 8); }
#pragma unroll 1
            for (int k2 = 0; k2 < 8; ++k2) {
#pragma unroll
                for (int i = 0; i < 8; ++i) *(LAS u32x4*)(Vl + (kq + 4 * i) * V_ROW + l16 * 16) = vr[i];
                if (k2 < 7) {
#pragma unroll
                    for (int i = 0; i < 8; ++i) { const int s = idxl[32 * (k2 + 1) + kq + 4 * i]; vr[i] = *(const u32x4*)(kvb + (size_t)s * NPROJ + C_V + l16 * 8); }
                }
                const h16x8 Pf = *(const LAS h16x8*)(prow + (32 * k2 + 8 * kq) * 2);
#pragma unroll
                for (int g = 0; g < 2; ++g)
#pragma unroll
                    for (int nt = 0; nt < 4; ++nt) {
                        const LAS unsigned char* va = Vl + (8 * kq + (l16 >> 2)) * V_ROW + (g * 64 + 16 * nt + 4 * (l16 & 3)) * 2;
                        typedef short s16x4 __attribute__((ext_vector_type(4)));
                        const s16x4 t0 = __builtin_amdgcn_ds_read_tr16_b64_v4i16((LAS s16x4*)va), t1 = __builtin_amdgcn_ds_read_tr16_b64_v4i16((LAS s16x4*)(va + 4 * V_ROW));
                        const h16x4 f0 = __builtin_bit_cast(h16x4, t0), f1 = __builtin_bit_cast(h16x4, t1);
                        const h16x8 Vf = {f0[0], f0[1], f0[2], f0[3], f1[0], f1[1], f1[2], f1[3]};
                        O[g][nt] = __builtin_amdgcn_mfma_f32_16x16x32_f16(Pf, Vf, O[g][nt], 0, 0, 0);
                    }
            }
            float inv[4];
#pragma unroll
            for (int i = 0; i < 4; ++i) inv[i] = 1.f / __shfl(lsum, (4 * kq + i) & 7);
            float ss = 0.f; f32x4 Y[4];
#pragma unroll
            for (int nt = 0; nt < 4; ++nt) { const f32x4 o = kq == 0 ? O[0][nt] : O[1][nt];
#pragma unroll
                for (int i = 0; i < 4; ++i) { Y[nt][i] = o[i] * inv[i]; ss += Y[nt][i] * Y[nt][i]; } }
            if (kq >= 2) ss = 0.f;
            const float rstd = rsqrtf(wave_sum(ss) * (1.f / 512.f) + EPS);
            if (kq < 2) {
#pragma unroll
                for (int nt = 0; nt < 4; ++nt)
#pragma unroll
                    for (int i = 0; i < 4; ++i) { const int ch = (4 * kq + i) * 64 + 16 * nt + l16; MIX[(size_t)m * D + 512 + ch] = (h16)(Y[nt][i] * rstd * args.in[I_ATTN][ch]); }
            }
        }
    }
    SEAM(8);
    if (IN(9)) {
        pg8::Gemm g{MIX, WOUT, M, D, D}; pg8::StaticOrder S; S.init(M, D, G, bx);
        pg8::EpiF32 E{MIXO, D};
        pg8::gemm_phase<pg8::EpiF32, pg8::StaticOrder, true, true>(lds, g, S, E);
    }
    SEAM(9);
    if (IN(10)) {
        const float* w1p = args.in[I_N1POST]; const float* w2p = args.in[I_N2PRE];
        for (int m = gw; m < M; m += NGW) {
            const int b = m / T; const float* md = MOD + (size_t)b * 6 * D; const f32x4* mr = (const f32x4*)(MIXO + (size_t)m * D) + lane; const f32x4* xr = (const f32x4*)(x + (size_t)m * D) + lane;
            f32x4 v[4]; float ss = 0.f;
#pragma unroll
            for (int j = 0; j < 4; ++j) { v[j] = mr[64 * j]; ss += (v[j].x * v[j].x + v[j].y * v[j].y) + (v[j].z * v[j].z + v[j].w * v[j].w); }
            float rstd = rsqrtf(wave_sum(ss) * (1.f / D) + EPS); ss = 0.f;
            f32x4* orow = (f32x4*)(out + (size_t)m * D) + lane;
#pragma unroll
            for (int j = 0; j < 4; ++j) { const int k = 4 * lane + 256 * j; const f32x4 gt = *(const f32x4*)(md + 2 * D + k), wp = *(const f32x4*)(w1p + k);
                v[j] = xr[64 * j] + gt * (v[j] * rstd * wp); orow[64 * j] = v[j]; ss += (v[j].x * v[j].x + v[j].y * v[j].y) + (v[j].z * v[j].z + v[j].w * v[j].w); }
            rstd = rsqrtf(wave_sum(ss) * (1.f / D) + EPS);
            u32x2* o8 = (u32x2*)(XN + (size_t)m * D) + lane;
#pragma unroll
            for (int j = 0; j < 4; ++j) { const int k = 4 * lane + 256 * j; const f32x4 gg = *(const f32x4*)(w2p + k), sh = *(const f32x4*)(md + 3 * D + k), sc = *(const f32x4*)(md + 4 * D + k);
                const f32x4 r = v[j] * rstd * gg * (sc + 1.f) + sh; u32x2 w; w.x = pk_h2(r.x, r.y); w.y = pk_h2(r.z, r.w); o8[64 * j] = w; }
        }
    }
    SEAM(10);
    if (IN(11)) {
        pg8::Gemm g{XN, W1, M, FF, D}; pg8::StaticOrder S; S.init(M, FF, G, bx);
        pg8::EpiH16<1, false> E{HB, FF, nullptr};
        pg8::gemm_phase<pg8::EpiH16<1, false>, pg8::StaticOrder, true, true>(lds, g, S, E);
    }
    SEAM(11);
    if (IN(12)) {
        pg8::Gemm g{HB, W2, M, D, FF}; pg8::StaticOrder S; S.init(M, D, G, bx);
        pg8::EpiF32 E{FB, D};
        pg8::gemm_phase<pg8::EpiF32, pg8::StaticOrder, true, true>(lds, g, S, E);
    }
    SEAM(12);
    if (IN(13)) {
        const float* w2post = args.in[I_N2POST];
        for (int m = gw; m < M; m += NGW) {
            const int b = m / T; const float* md = MOD + (size_t)b * 6 * D; const f32x4* fr = (const f32x4*)(FB + (size_t)m * D) + lane;
            f32x4 v[4]; float ss = 0.f;
#pragma unroll
            for (int j = 0; j < 4; ++j) { v[j] = fr[64 * j]; ss += (v[j].x * v[j].x + v[j].y * v[j].y) + (v[j].z * v[j].z + v[j].w * v[j].w); }
            const float rstd = rsqrtf(wave_sum(ss) * (1.f / D) + EPS);
            f32x4* orow = (f32x4*)(out + (size_t)m * D) + lane;
#pragma unroll
            for (int j = 0; j < 4; ++j) { const int k = 4 * lane + 256 * j; const f32x4 gt = *(const f32x4*)(md + 5 * D + k), wp = *(const f32x4*)(w2post + k);
                orow[64 * j] = orow[64 * j] + gt * (v[j] * rstd * wp); }
        }
    }
#undef IN
#undef SEAM
}

static int g_grid = 0;
static void mk_launch(Args& a, int lo, int hi, int li, hipStream_t stream) {
    a.ph_lo = lo; a.ph_hi = hi; a.li = li;
    hipLaunchKernelGGL(mk_fwd, dim3(g_grid), dim3(NTHR), LDS_BYTES, stream, a);
}

extern "C" void kernel_launch(void* const* d_in, const int* in_sizes, int n_in, void* d_out, int out_size, void* d_ws, size_t ws_size, hipStream_t stream) {
    const float* x = (const float*)d_in[0]; const float* c = (const float*)d_in[1]; const float* w_ada = (const float*)d_in[2]; const float* b_ada = (const float*)d_in[3];
    const float* norm1_pre = (const float*)d_in[4]; const float* norm1_post = (const float*)d_in[5]; const float* w_in = (const float*)d_in[6];
    const float* conv_w = (const float*)d_in[7]; const float* conv_b = (const float*)d_in[8]; const float* dt_bias = (const float*)d_in[9];
    const float* a_log = (const float*)d_in[10]; const float* d_skip = (const float*)d_in[11]; const float* ssm_norm = (const float*)d_in[12];
    const float* rel_bias = (const float*)d_in[13]; const float* attn_norm = (const float*)d_in[14]; const float* w_out = (const float*)d_in[15];
    const float* norm2_pre = (const float*)d_in[16]; const float* norm2_post = (const float*)d_in[17]; const float* w_mlp_in = (const float*)d_in[18]; const float* w_mlp_out = (const float*)d_in[19];
    unsigned char* ws = (unsigned char*)d_ws; unsigned char* dob = (unsigned char*)d_out; float* out = (float*)d_out;
    float* MOD = (float*)(ws + WS_MOD); float* PF32 = (float*)(ws + WS_PF32);
    h16* WIN = (h16*)(ws + WS_WIN); h16* WOUT = (h16*)(ws + WS_WOUT); h16* W1 = (h16*)(ws + WS_W1); h16* W2 = (h16*)(ws + WS_W2);
    h16* XN = (h16*)(ws + WS_XN); h16* PROJ = (h16*)(ws + WS_PROJ); h16* MIX = (h16*)(ws + WS_MIX); unsigned short* IDX = (unsigned short*)(ws + WS_IDX);
    float* YTMP = (float*)(ws + WS_YTMP); float* DTV = (float*)(ws + WS_DT); float* MIXO = (float*)(ws + WS_MIXO); h16* HB = (h16*)(ws + WS_H); float* FB = (float*)(ws + WS_F);
    h16* XC = (h16*)(dob + DO_XC); float* SLAB = (float*)dob;

    if (g_grid == 0) {
        int dev = 0, cus = 0;
        if (hipGetDevice(&dev) != hipSuccess || hipDeviceGetAttribute(&cus, hipDeviceAttributeMultiprocessorCount, dev) != hipSuccess) { fprintf(stderr, "kernel_launch: device query failed\n"); g_grid = -1; return; }
        if (hipFuncSetAttribute((const void*)mk_fwd, hipFuncAttributeMaxDynamicSharedMemorySize, LDS_BYTES) != hipSuccess) { fprintf(stderr, "kernel_launch: hipFuncSetAttribute failed\n"); g_grid = -1; return; }
        g_grid = cus;
        if (ws_size < 256 * MiB) fprintf(stderr, "kernel_launch: workspace too small: %zu\n", ws_size);
    }
    if (g_grid < 0) return;
    (void)hipMemsetAsync(ws + WS_CTL, 0, CTL_ZERO_BYTES, stream);
    Args a{};
    for (int i = 0; i < 20; ++i) a.in[i] = (const float*)d_in[i];
    a.out = out; a.ws = ws;
    int li = 0;
    mk_launch(a, 0, 3, li++, stream);
    mk_launch(a, 3, 7, li++, stream);
    mk_launch(a, 7, 8, li++, stream);
    mk_launch(a, 8, 14, li++, stream);
}
```

```cpp
#include <hip/hip_runtime.h>
#include <cstdio>
#include <cstdint>

typedef _Float16 h16;
typedef _Float16 h16x4 __attribute__((ext_vector_type(4)));
typedef _Float16 h16x8 __attribute__((ext_vector_type(8)));
typedef float f32x4 __attribute__((ext_vector_type(4)));

constexpr int NB = 2, T = 8192, D = 1024, M = NB * T, FF = 4096;
constexpr int NPROJ = 3072;
constexpr int C_Z = 0, C_XBC = 512, C_Q = 1536, C_K = 2048, C_V = 2176, C_QI = 2304, C_KI = 2816, C_DT = 2880, C_WI = 2888, C_END = 2896;
constexpr float EPS = 1e-6f;
constexpr int TOPK = 256;

constexpr size_t MiB = 1u << 20;
constexpr size_t WS_CTL = 0, WS_MOD = 1 * MiB, WS_PF32 = 2 * MiB;
constexpr size_t WS_WIN = 4 * MiB, WS_WOUT = 10 * MiB, WS_W1 = 12 * MiB, WS_W2 = 20 * MiB;
constexpr size_t WS_XN = 28 * MiB, WS_PROJ = 60 * MiB;
constexpr size_t WS_STATES = 156 * MiB, WS_PREV = 172 * MiB, WS_DT = 180 * MiB, WS_ACS = WS_DT + 512 * 1024;
constexpr size_t WS_MIX = 181 * MiB, WS_IDX = 213 * MiB, WS_YTMP = 221 * MiB;
constexpr size_t WS_MIXO = 60 * MiB, WS_H = 60 * MiB, WS_F = 188 * MiB;
constexpr size_t DO_XC = 0, DO_XST = 32 * MiB, DO_BT = 48 * MiB;

__device__ __forceinline__ float silu_f(float x) { return x / (1.f + __expf(-x)); }
__device__ __forceinline__ float softplus_f(float x) { return fmaxf(x, 0.f) + log1pf(__expf(-fabsf(x))); }
__device__ __forceinline__ float wave_sum(float v) {
#pragma unroll
    for (int o = 1; o < 64; o <<= 1) v += __shfl_xor(v, o);
    return v;
}
__device__ __forceinline__ int win_src(int n) {
    if (n < C_Q) return n;
    if (n < C_DT) return n + 8;
    if (n < C_WI) return n - C_DT + 1536;
    if (n < C_END) return n;
    return -1;
}
__device__ __forceinline__ int t5_bucket(int n) {
    if (n < 16) return n;
    int b = 16;
    b += (n >= 19); b += (n >= 21); b += (n >= 24); b += (n >= 27); b += (n >= 31); b += (n >= 35); b += (n >= 40); b += (n >= 46);
    b += (n >= 52); b += (n >= 59); b += (n >= 67); b += (n >= 77); b += (n >= 87); b += (n >= 99); b += (n >= 113);
    return b;
}
__device__ __forceinline__ unsigned fkey(float f) { unsigned u = __float_as_uint(f); return (u & 0x80000000u) ? ~u : (u | 0x80000000u); }

namespace nv {
__global__ void prep_w(const float* W, int K, int N, h16* WT, int NT, int mode) {
    const size_t i = (size_t)blockIdx.x * blockDim.x + threadIdx.x; if (i >= (size_t)NT * K) return;
    const int n = (int)(i / K), k = (int)(i % K); const int s = mode ? win_src(n) : n;
    WT[i] = (h16)(s < 0 ? 0.f : W[(size_t)k * N + s]);
}
__global__ void modk(const float* c, const float* w_ada, const float* b_ada, float* mod) {
    const int j = blockIdx.x * blockDim.x + threadIdx.x; if (j >= NB * 6 * D) return;
    const int b = j / (6 * D), jj = j % (6 * D); float acc = b_ada[jj];
    for (int k = 0; k < D; ++k) acc += silu_f(c[b * D + k]) * w_ada[(size_t)k * 6 * D + jj];
    mod[j] = acc;
}
__global__ void norm_mod(const float* x, const float* g, const float* mod, int ci, h16* xn) {
    const int m = blockIdx.x * (blockDim.x / 64) + (threadIdx.x >> 6), lane = threadIdx.x & 63; if (m >= M) return;
    const int b = m / T; const float* xr = x + (size_t)m * D; float v[16]; float ss = 0.f;
#pragma unroll
    for (int j = 0; j < 16; ++j) { v[j] = xr[lane + 64 * j]; ss += v[j] * v[j]; }
    const float rstd = rsqrtf(wave_sum(ss) * (1.f / D) + EPS);
    const float* sh = mod + (size_t)b * 6 * D + ci * D; const float* sc = sh + D;
#pragma unroll
    for (int j = 0; j < 16; ++j) { const int k = lane + 64 * j; xn[(size_t)m * D + k] = (h16)(v[j] * rstd * g[k] * (1.f + sc[k]) + sh[k]); }
}
struct EpiProj { h16* proj; float* pf32;
    __device__ void operator()(int m, int n, float v) const { proj[(size_t)m * NPROJ + n] = (h16)v; if (n >= C_DT && n < C_END) pf32[(size_t)m * 16 + (n - C_DT)] = v; } };
struct EpiF32 { float* C; int ldc; __device__ void operator()(int m, int n, float v) const { C[(size_t)m * ldc + n] = v; } };
struct EpiRelu2 { h16* C; int ldc; __device__ void operator()(int m, int n, float v) const { const float r = fmaxf(v, 0.f); C[(size_t)m * ldc + n] = (h16)(r * r); } };
template <class Epi> __global__ void __launch_bounds__(256) gemm(const h16* A, const h16* Bt, int Mm, int N, int K, Epi epi) {
    __shared__ float As[16][65], Bs[16][65];
    const int tid = threadIdx.x, tx = tid & 15, ty = tid >> 4, m0 = blockIdx.y * 64, n0 = blockIdx.x * 64;
    float acc[4][4] = {};
    const int lr = tid >> 2, lk = (tid & 3) * 4;
    for (int k0 = 0; k0 < K; k0 += 16) {
        const h16x4 a = *(const h16x4*)(A + (size_t)(m0 + lr) * K + k0 + lk), b = *(const h16x4*)(Bt + (size_t)(n0 + lr) * K + k0 + lk);
#pragma unroll
        for (int j = 0; j < 4; ++j) { As[lk + j][lr] = (float)a[j]; Bs[lk + j][lr] = (float)b[j]; }
        __syncthreads();
#pragma unroll
        for (int k = 0; k < 16; ++k) { float av[4], bv[4];
#pragma unroll
            for (int i = 0; i < 4; ++i) { av[i] = As[k][ty * 4 + i]; bv[i] = Bs[k][tx * 4 + i]; }
#pragma unroll
            for (int i = 0; i < 4; ++i)
#pragma unroll
                for (int j = 0; j < 4; ++j) acc[i][j] += av[i] * bv[j]; }
        __syncthreads();
    }
#pragma unroll
    for (int i = 0; i < 4; ++i)
#pragma unroll
        for (int j = 0; j < 4; ++j) epi(m0 + ty * 4 + i, n0 + tx * 4 + j, acc[i][j]);
}
__global__ void conv(const h16* proj, const float* pf32, const float* cw, const float* cb, const float* dt_bias, h16* xc, float* dtv) {
    const size_t i = (size_t)blockIdx.x * blockDim.x + threadIdx.x; if (i >= (size_t)M * 1024) return;
    const int m = (int)(i >> 10), ch = (int)(i & 1023), t = m % T; float acc = cb[ch];
#pragma unroll
    for (int w = 0; w < 4; ++w) { const int tt = t - 3 + w; if (tt >= 0) acc += cw[w * 1024 + ch] * (float)proj[(size_t)(m - 3 + w) * NPROJ + C_XBC + ch]; }
    xc[i] = (h16)silu_f(acc);
    if (ch < 8) dtv[(size_t)m * 8 + ch] = softplus_f(pf32[(size_t)m * 16 + ch] + dt_bias[ch]);
}
__global__ void __launch_bounds__(64) ssd_rec(const h16* xc, const float* dtv, const float* a_log, const float* d_skip, float* y) {
    const int b = blockIdx.x / 8, h = blockIdx.x % 8, g = h / 4, p = threadIdx.x;
    const float a = -__expf(a_log[h]), dsk = d_skip[h]; float st[128];
#pragma unroll
    for (int n = 0; n < 128; ++n) st[n] = 0.f;
    for (int t = 0; t < T; ++t) {
        const size_t m = (size_t)b * T + t; const float dt = dtv[m * 8 + h], dA = __expf(a * dt), xs = (float)xc[m * 1024 + h * 64 + p], xdt = xs * dt;
        const h16* Bp = xc + m * 1024 + 512 + g * 128; const h16* Cp = xc + m * 1024 + 768 + g * 128; float acc = 0.f;
#pragma unroll
        for (int n = 0; n < 128; ++n) { st[n] = st[n] * dA + (float)Bp[n] * xdt; acc += (float)Cp[n] * st[n]; }
        y[m * 512 + h * 64 + p] = acc + dsk * xs;
    }
}
__global__ void norm512(const float* y, const h16* proj, int gate, const float* w, h16* mix, int coff) {
    const int m = blockIdx.x * (blockDim.x / 64) + (threadIdx.x >> 6), lane = threadIdx.x & 63; if (m >= M) return;
    float v[8]; float ss = 0.f;
#pragma unroll
    for (int j = 0; j < 8; ++j) { const int k = lane + 64 * j; float u = y[(size_t)m * 512 + k]; if (gate) u *= silu_f((float)proj[(size_t)m * NPROJ + C_Z + k]); v[j] = u; ss += u * u; }
    const float rstd = rsqrtf(wave_sum(ss) * (1.f / 512.f) + EPS);
#pragma unroll
    for (int j = 0; j < 8; ++j) { const int k = lane + 64 * j; mix[(size_t)m * D + coff + k] = (h16)(v[j] * rstd * w[k]); }
}
__global__ void __launch_bounds__(256) scores(const h16* proj, const float* pf32, int q0, float* slab) {
    __shared__ float qs[512]; __shared__ float ws[8];
    const int ql = blockIdx.y, m = q0 + ql, t = m % T, b = m / T, s = blockIdx.x * 256 + threadIdx.x;
    if (blockIdx.x * 256 > t) return;
    for (int i = threadIdx.x; i < 512; i += 256) qs[i] = (float)proj[(size_t)m * NPROJ + C_QI + i];
    if (threadIdx.x < 8) ws[threadIdx.x] = pf32[(size_t)m * 16 + 8 + threadIdx.x] * 0.35355339059327373f * 0.125f;
    __syncthreads();
    float kv[64]; const h16* kp = proj + (size_t)(b * T + s) * NPROJ + C_KI;
#pragma unroll
    for (int d = 0; d < 64; ++d) kv[d] = (float)kp[d];
    float sc = 0.f;
    for (int h = 0; h < 8; ++h) { float dot = 0.f;
#pragma unroll
        for (int d = 0; d < 64; ++d) dot += qs[h * 64 + d] * kv[d];
        sc += ws[h] * fmaxf(dot, 0.f); }
    slab[(size_t)ql * T + s] = sc;
}
__global__ void __launch_bounds__(256) select(const float* slab, int q0, unsigned short* idx) {
    __shared__ unsigned red[256]; __shared__ unsigned sh_cnt;
    const int ql = blockIdx.x, m = q0 + ql, t = m % T, n = t + 1, tid = threadIdx.x;
    unsigned short* out = idx + (size_t)m * TOPK;
    if (n <= TOPK) { out[tid] = (unsigned short)(tid < n ? tid : 0); return; }
    unsigned key[32];
#pragma unroll
    for (int j = 0; j < 32; ++j) { const int i = tid * 32 + j; key[j] = i < n ? fkey(slab[(size_t)ql * T + i]) : 0u; }
    unsigned Kt = 0u;
    for (int bit = 31; bit >= 0; --bit) {
        const unsigned cand = Kt | (1u << bit); unsigned c = 0;
#pragma unroll
        for (int j = 0; j < 32; ++j) c += (key[j] >= cand);
        if (tid == 0) sh_cnt = 0u; __syncthreads();
        atomicAdd(&sh_cnt, c); __syncthreads();
        if (sh_cnt >= (unsigned)TOPK) Kt = cand;
        __syncthreads();
    }
    unsigned cg = 0, ce = 0;
#pragma unroll
    for (int j = 0; j < 32; ++j) { cg += (key[j] > Kt); ce += (key[j] == Kt); }
    red[tid] = (cg << 16) | ce; __syncthreads();
    unsigned pg = 0, pe = 0, tg = 0;
    for (int i = 0; i < 256; ++i) { const unsigned r = red[i]; if (i < tid) { pg += r >> 16; pe += r & 0xffffu; } tg += r >> 16; }
    const unsigned need = (unsigned)TOPK - tg;
    unsigned sel_before = pg + (pe < need ? pe : need);
#pragma unroll
    for (int j = 0; j < 32; ++j) {
        bool s = false;
        if (key[j] > Kt) s = true; else if (key[j] == Kt) { s = pe < need; ++pe; }
        if (s) { out[sel_before] = (unsigned short)(tid * 32 + j); ++sel_before; }
    }
}
__global__ void __launch_bounds__(256) attn(const h16* proj, const unsigned short* idx, const float* rel_bias, float* y) {
    const int gid = blockIdx.x * 256 + threadIdx.x, m = gid >> 3, h = gid & 7, g = h >> 2, t = m % T, b = m / T;
    const int cnt = (t + 1 < TOPK) ? t + 1 : TOPK;
    float q[64], acc[64];
#pragma unroll
    for (int d = 0; d < 64; ++d) { q[d] = (float)proj[(size_t)m * NPROJ + C_Q + h * 64 + d] * 0.125f; acc[d] = 0.f; }
    float mx = -INFINITY, l = 0.f;
    for (int j = 0; j < cnt; ++j) {
        const int s = idx[(size_t)m * TOPK + j]; const h16* kp = proj + (size_t)(b * T + s) * NPROJ + C_K + g * 64; const h16* vp = kp + (C_V - C_K);
        float lg = rel_bias[t5_bucket(t - s) * 8 + h];
#pragma unroll
        for (int d = 0; d < 64; ++d) lg += q[d] * (float)kp[d];
        const float mn = fmaxf(mx, lg), sc = __expf(mx - mn), pe = __expf(lg - mn);
        l = l * sc + pe; mx = mn;
#pragma unroll
        for (int d = 0; d < 64; ++d) acc[d] = acc[d] * sc + pe * (float)vp[d];
    }
    const float inv = 1.f / l;
#pragma unroll
    for (int d = 0; d < 64; ++d) y[(size_t)m * 512 + h * 64 + d] = acc[d] * inv;
}
__global__ void post1(const float* x, const float* mixo, const float* mod, const float* w1post, const float* w2pre, float* out, h16* xn) {
    const int m = blockIdx.x * (blockDim.x / 64) + (threadIdx.x >> 6), lane = threadIdx.x & 63; if (m >= M) return;
    const int b = m / T; const float* md = mod + (size_t)b * 6 * D; float v[16]; float ss = 0.f;
#pragma unroll
    for (int j = 0; j < 16; ++j) { v[j] = mixo[(size_t)m * D + lane + 64 * j]; ss += v[j] * v[j]; }
    float rstd = rsqrtf(wave_sum(ss) * (1.f / D) + EPS); ss = 0.f;
#pragma unroll
    for (int j = 0; j < 16; ++j) { const int k = lane + 64 * j; v[j] = x[(size_t)m * D + k] + md[2 * D + k] * (v[j] * rstd * w1post[k]); out[(size_t)m * D + k] = v[j]; ss += v[j] * v[j]; }
    rstd = rsqrtf(wave_sum(ss) * (1.f / D) + EPS);
#pragma unroll
    for (int j = 0; j < 16; ++j) { const int k = lane + 64 * j; xn[(size_t)m * D + k] = (h16)(v[j] * rstd * w2pre[k] * (1.f + md[4 * D + k]) + md[3 * D + k]); }
}
__global__ void post2(const float* f, const float* mod, const float* w2post, float* out) {
    const int m = blockIdx.x * (blockDim.x / 64) + (threadIdx.x >> 6), lane = threadIdx.x & 63; if (m >= M) return;
    const int b = m / T; const float* md = mod + (size_t)b * 6 * D; float v[16]; float ss = 0.f;
#pragma unroll
    for (int j = 0; j < 16; ++j) { v[j] = f[(size_t)m * D + lane + 64 * j]; ss += v[j] * v[j]; }
    const float rstd = rsqrtf(wave_sum(ss) * (1.f / D) + EPS);
#pragma unroll
    for (int j = 0; j < 16; ++j) { const int k = lane + 64 * j; out[(size_t)m * D + k] += md[5 * D + k] * (v[j] * rstd * w2post[k]); }
}
}


#define LAS __attribute__((address_space(3)))
#define GAS __attribute__((address_space(1)))
typedef unsigned u32x4 __attribute__((ext_vector_type(4)));
typedef unsigned u32x2 __attribute__((ext_vector_type(2)));
typedef float f32x2 __attribute__((ext_vector_type(2)));
typedef _Float16 h16x2 __attribute__((ext_vector_type(2)));
typedef float f32x16 __attribute__((ext_vector_type(16)));
__device__ __forceinline__ unsigned pk_h2(float lo, float hi) { const f32x2 v = {lo, hi}; const h16x2 h = __builtin_convertvector(v, h16x2); return __builtin_bit_cast(unsigned, h); }

namespace pg8 {
constexpr int BM = 256, BK = 64, HALF = 128, HTB = HALF * BK * 2, STAGE_BYTES = 8 * HTB, NXCD = 8, WGM = 8;
__host__ __device__ __forceinline__ int lds_byte(int r, int c) { const int st = (r >> 4) * 2 + (c >> 5), rr = r & 15, cc = c & 31, ob = rr * 64 + cc * 2; return st * 1024 + (ob ^ (((ob >> 9) & 1) << 5)); }
__host__ __device__ __forceinline__ void stage_rc(int b, int& R, int& C) { const int st = b / 1024, sb = b % 1024, swz = sb ^ (((sb >> 9) & 1) << 5); R = (st >> 1) * 16 + swz / 64; C = (st & 1) * 32 + (swz % 64) / 2; }
__host__ __device__ __forceinline__ int perm32(int rho) { const int n = rho >> 4, i = rho & 15; return 8 * (i >> 2) + 4 * n + (i & 3); }
struct Unit { int pm, pn; };
struct Gemm { const h16* A; const h16* Bt; int M, N, K; };
struct StaticOrder {
    int nM, nN, nwg, G, c;
    __host__ __device__ void init(int M_, int N_, int G_, int c_) { nM = M_ / BM; nN = N_ / BM; nwg = nM * nN; G = G_; c = c_; }
    __host__ __device__ bool next(int i, Unit& u) const {
        const long L = (long)i * G + c; if (L >= nwg) return false;
        int wgid = (int)L; { const int q = nwg / NXCD, r = nwg % NXCD, xcd = wgid % NXCD, off = wgid / NXCD; wgid = (xcd < r ? xcd * (q + 1) : r * (q + 1) + (xcd - r) * q) + off; }
        const int nig = WGM * nN, gid = wgid / nig, fm = gid * WGM, gsz = (nM - fm) < WGM ? (nM - fm) : WGM;
        u.pm = fm + ((wgid % nig) % gsz); u.pn = (wgid % nig) / gsz; return true;
    }
    __device__ __forceinline__ void a_ready(const Unit&) const {}
    __device__ __forceinline__ void done(const Unit&) const {}
};
struct EpiF32 {
    static constexpr bool PERM = false, AFTER_DRAIN = false;
    float* C; int ldc;
    __device__ __forceinline__ void operator()(const f32x4 (&acc)[2][2][4][2], const Unit& u, int wr, int wc, int fr, int fq) const {
        const int row0 = u.pm * BM + wr * 64 + fr, col0 = u.pn * BM + wc * 32 + 4 * fq;
#pragma unroll
        for (int ai = 0; ai < 2; ++ai)
#pragma unroll
            for (int m = 0; m < 4; ++m) { float* rowp = C + (size_t)(row0 + ai * HALF + m * 16) * ldc + col0;
#pragma unroll
                for (int bj = 0; bj < 2; ++bj)
#pragma unroll
                    for (int n = 0; n < 2; ++n) *(f32x4*)(rowp + bj * HALF + n * 16) = acc[ai][bj][m][n]; }
    }
};
template <int ACT  , bool SIDE  > struct EpiH16 {
    static constexpr bool PERM = true, AFTER_DRAIN = false;
    h16* O; int ldc; float* pf32;
    __device__ __forceinline__ void operator()(const f32x4 (&acc)[2][2][4][2], const Unit& u, int wr, int wc, int fr, int fq) const {
        const int row0 = u.pm * BM + wr * 64 + fr, col0 = u.pn * BM + wc * 32 + 8 * fq;
#pragma unroll
        for (int ai = 0; ai < 2; ++ai)
#pragma unroll
            for (int m = 0; m < 4; ++m) { h16* rowp = O + (size_t)(row0 + ai * HALF + m * 16) * ldc + col0;
#pragma unroll
                for (int bj = 0; bj < 2; ++bj) { f32x4 v0 = acc[ai][bj][m][0], v1 = acc[ai][bj][m][1];
                    if (ACT == 1) {
#pragma unroll
                        for (int j = 0; j < 4; ++j) { const float a = fmaxf(v0[j], 0.f), b = fmaxf(v1[j], 0.f); v0[j] = a * a; v1[j] = b * b; } }
                    u32x4 w; w.x = pk_h2(v0[0], v0[1]); w.y = pk_h2(v0[2], v0[3]); w.z = pk_h2(v1[0], v1[1]); w.w = pk_h2(v1[2], v1[3]);
                    *(u32x4*)(rowp + bj * HALF) = w;
                    if (SIDE) { if (bj == 0 && u.pn * BM + 64 == C_DT && wc == 2 && fq < 2) {
                        float* sp = pf32 + (size_t)(row0 + ai * HALF + m * 16) * 16 + 8 * fq; *(f32x4*)sp = acc[ai][0][m][0]; *(f32x4*)(sp + 4) = acc[ai][0][m][1]; } }
                } }
    }
};
template <class Epi, class Sched, bool ALIGN_EPI = false, bool SP2 = false>
__device__ __forceinline__ void gemm_phase(LAS unsigned char* lds, const Gemm g, const Sched& S, const Epi& E) {
    const int tid = threadIdx.x, wid = __builtin_amdgcn_readfirstlane(tid >> 6), lane = tid & 63, wr = wid >> 2, wc = wid & 3, fr = lane & 15, fq = lane >> 4;
    const int K = g.K, nt = K / BK;
    unsigned voffA[2], voffB[2];
#pragma unroll
    for (int i = 0; i < 2; ++i) { int R, C; stage_rc(tid * 16 + i * 8192, R, C); const int Rb = Epi::PERM ? ((R & ~31) + perm32(R & 31)) : R;
        voffA[i] = (unsigned)(R * K + C) * 2u; voffB[i] = (unsigned)(Rb * K + C) * 2u; }
    const size_t kstep = (size_t)(BK * 2);
    const size_t hstep = (size_t)HALF * K * 2;
    const size_t tstep = 2 * hstep;
    const unsigned ldsw = (unsigned)wid * 1024u;
    const int aoff = lds_byte(wr * 64 + fr, fq * 8), boff = lds_byte(wc * 32 + fr, fq * 8);
#define PG8_SA(b, h) (((b) * 2 + (h)) * HTB)
#define PG8_SB(b, h) ((4 + (b) * 2 + (h)) * HTB)
#define PG8_STAGE(bufoff, gbase, voff) do { _Pragma("unroll") for (int _i = 0; _i < 2; ++_i) \
        __builtin_amdgcn_global_load_lds((const unsigned*)((const char*)(gbase) + (voff)[_i]), (LAS unsigned*)(lds + (bufoff) + ldsw + _i * 8192), 16, 0, 0); } while (0)
#define PG8_LDA(dst, b, h) do { _Pragma("unroll") for (int m = 0; m < 4; ++m) _Pragma("unroll") for (int k = 0; k < 2; ++k) dst[m][k] = *(const LAS h16x8*)(lds + PG8_SA(b, h) + aoff + m * 2048 + k * 1024); } while (0)
#define PG8_LDB(dst, b, h) do { _Pragma("unroll") for (int n = 0; n < 2; ++n) _Pragma("unroll") for (int k = 0; k < 2; ++k) dst[n][k] = *(const LAS h16x8*)(lds + PG8_SB(b, h) + boff + n * 2048 + k * 1024); } while (0)
#define PG8_MMA(ai, bj, At, Bt) do { __builtin_amdgcn_s_setprio(1); _Pragma("unroll") for (int m = 0; m < 4; ++m) _Pragma("unroll") for (int n = 0; n < 2; ++n) _Pragma("unroll") for (int k = 0; k < 2; ++k) \
        acc[ai][bj][m][n] = __builtin_amdgcn_mfma_f32_16x16x32_f16(Bt[n][k], At[m][k], acc[ai][bj][m][n], 0, 0, 0); __builtin_amdgcn_s_setprio(0); } while (0)
#define PG8_WAIT_V(n) asm volatile("s_waitcnt vmcnt(" #n ")" ::: "memory")
#define PG8_WAIT_L(n) asm volatile("s_waitcnt lgkmcnt(" #n ")" ::: "memory")
#define PG8_BAR __builtin_amdgcn_s_barrier()
#define PG8_SCHED __builtin_amdgcn_sched_barrier(0)
    Unit cur, nxt; int ui = 0;
    if (!S.next(0, cur)) return;
    f32x4 acc[2][2][4][2];
#pragma unroll
    for (int a = 0; a < 2; ++a)
#pragma unroll
        for (int b = 0; b < 2; ++b)
#pragma unroll
            for (int m = 0; m < 4; ++m)
#pragma unroll
                for (int n = 0; n < 2; ++n) acc[a][b][m][n] = (f32x4){0.f, 0.f, 0.f, 0.f};
    h16x8 At[4][2], B0[2][2], B1[2][2];
    const char* cA = (const char*)g.A + (size_t)cur.pm * tstep; const char* cB = (const char*)g.Bt + (size_t)cur.pn * tstep;
    S.a_ready(cur);
    if constexpr (SP2) {
        PG8_STAGE(PG8_SB(0, 0), cB, voffB); PG8_STAGE(PG8_SB(0, 1), cB + hstep, voffB); PG8_STAGE(PG8_SA(0, 0), cA, voffA); PG8_STAGE(PG8_SA(0, 1), cA + hstep, voffA);
        if (wr == 1) PG8_BAR;
        PG8_WAIT_V(2); PG8_BAR;
        PG8_STAGE(PG8_SB(1, 0), cB + kstep, voffB); PG8_STAGE(PG8_SA(1, 0), cA + kstep, voffA); PG8_STAGE(PG8_SB(1, 1), cB + hstep + kstep, voffB);
        PG8_WAIT_V(6); PG8_BAR;
    } else {
        PG8_STAGE(PG8_SB(0, 0), cB, voffB); PG8_STAGE(PG8_SA(0, 0), cA, voffA); PG8_STAGE(PG8_SB(0, 1), cB + hstep, voffB); PG8_STAGE(PG8_SA(0, 1), cA + hstep, voffA);
        if (wr == 1) PG8_BAR;
        PG8_WAIT_V(4); PG8_BAR;
        PG8_STAGE(PG8_SB(1, 0), cB + kstep, voffB); PG8_STAGE(PG8_SA(1, 0), cA + kstep, voffA); PG8_STAGE(PG8_SB(1, 1), cB + hstep + kstep, voffB);
        PG8_WAIT_V(6); PG8_BAR;
    }
    for (;;) {
        const bool has_next = S.next(ui + 1, nxt);
        const char* nA = has_next ? (const char*)g.A + (size_t)nxt.pm * tstep : cA; const char* nB = has_next ? (const char*)g.Bt + (size_t)nxt.pn * tstep : cB;
        for (int t = 0; t < nt; t += 2) {
            const bool last = (t == nt - 2);
            const char* a1 = cA + (size_t)(t + 1) * kstep;
            const char* a2 = last ? nA : cA + (size_t)(t + 2) * kstep; const char* b2 = last ? nB : cB + (size_t)(t + 2) * kstep;
            const char* a3 = a2 + kstep; const char* b3 = b2 + kstep;
            if (last && has_next) S.a_ready(nxt);
            if constexpr (SP2) {
            PG8_LDB(B0, 0, 0); PG8_LDB(B1, 0, 1); PG8_SCHED; PG8_LDA(At, 0, 0); PG8_STAGE(PG8_SA(1, 1), a1 + hstep, voffA);
            PG8_WAIT_V(8); PG8_WAIT_L(0); PG8_BAR; PG8_MMA(0, 0, At, B0); PG8_MMA(0, 1, At, B1); PG8_BAR; PG8_SCHED;
            PG8_LDA(At, 0, 1); PG8_STAGE(PG8_SB(0, 0), b2, voffB); PG8_STAGE(PG8_SB(0, 1), b2 + hstep, voffB); PG8_STAGE(PG8_SA(0, 0), a2, voffA);
            PG8_WAIT_V(8); PG8_WAIT_L(0); PG8_BAR; PG8_MMA(1, 0, At, B0); PG8_MMA(1, 1, At, B1); PG8_BAR; PG8_SCHED;
            PG8_LDB(B0, 1, 0); PG8_LDB(B1, 1, 1); PG8_SCHED; PG8_LDA(At, 1, 0); PG8_STAGE(PG8_SA(0, 1), a2 + hstep, voffA);
            PG8_WAIT_V(8); PG8_WAIT_L(0); PG8_BAR; PG8_MMA(0, 0, At, B0); PG8_MMA(0, 1, At, B1); PG8_BAR; PG8_SCHED;
            PG8_LDA(At, 1, 1); PG8_STAGE(PG8_SB(1, 0), b3, voffB); PG8_STAGE(PG8_SB(1, 1), b3 + hstep, voffB); PG8_STAGE(PG8_SA(1, 0), a3, voffA);
            PG8_WAIT_V(8); PG8_WAIT_L(0); PG8_BAR; PG8_MMA(1, 0, At, B0); PG8_MMA(1, 1, At, B1); PG8_BAR; PG8_SCHED;
            } else {
            PG8_LDB(B0, 0, 0); PG8_SCHED; PG8_LDA(At, 0, 0); PG8_STAGE(PG8_SA(1, 1), a1 + hstep, voffA);
            PG8_WAIT_L(8); PG8_BAR; PG8_WAIT_L(0); PG8_MMA(0, 0, At, B0); PG8_BAR; PG8_SCHED;
            PG8_LDB(B1, 0, 1); PG8_STAGE(PG8_SB(0, 0), b2, voffB);
            PG8_BAR; PG8_WAIT_L(0); PG8_MMA(0, 1, At, B1); PG8_BAR;
            PG8_LDA(At, 0, 1); PG8_STAGE(PG8_SA(0, 0), a2, voffA);
            PG8_BAR; PG8_WAIT_L(0); PG8_MMA(1, 0, At, B0); PG8_BAR; PG8_SCHED;
            PG8_STAGE(PG8_SB(0, 1), b2 + hstep, voffB);
            PG8_WAIT_V(6); PG8_BAR; PG8_MMA(1, 1, At, B1); PG8_BAR;
            PG8_LDB(B0, 1, 0); PG8_SCHED; PG8_LDA(At, 1, 0); PG8_STAGE(PG8_SA(0, 1), a2 + hstep, voffA);
            PG8_WAIT_L(8); PG8_BAR; PG8_WAIT_L(0); PG8_MMA(0, 0, At, B0); PG8_BAR; PG8_SCHED;
            PG8_LDB(B1, 1, 1); PG8_STAGE(PG8_SB(1, 0), b3, voffB);
            PG8_BAR; PG8_WAIT_L(0); PG8_MMA(0, 1, At, B1); PG8_BAR;
            PG8_LDA(At, 1, 1); PG8_STAGE(PG8_SA(1, 0), a3, voffA);
            PG8_BAR; PG8_WAIT_L(0); PG8_MMA(1, 0, At, B0); PG8_BAR; PG8_SCHED;
            PG8_STAGE(PG8_SB(1, 1), b3 + hstep, voffB);
            PG8_WAIT_V(6); PG8_BAR; PG8_MMA(1, 1, At, B1); PG8_BAR;
            }
        }
        if constexpr (ALIGN_EPI) { if (wr == 0) PG8_BAR; }
        if constexpr (!Epi::AFTER_DRAIN) { E(acc, cur, wr, wc, fr, fq); S.done(cur); }
        if (!has_next) break;
#pragma unroll
        for (int a = 0; a < 2; ++a)
#pragma unroll
            for (int b = 0; b < 2; ++b)
#pragma unroll
                for (int m = 0; m < 4; ++m)
#pragma unroll
                    for (int n = 0; n < 2; ++n) acc[a][b][m][n] = (f32x4){0.f, 0.f, 0.f, 0.f};
        cur = nxt; cA = nA; cB = nB; ++ui;
        if constexpr (ALIGN_EPI) { if (wr == 1) PG8_BAR; }
    }
    PG8_WAIT_V(0);
    if constexpr (!ALIGN_EPI) { if (wr == 0) PG8_BAR; }
    PG8_BAR;
    if constexpr (Epi::AFTER_DRAIN) { E.fused(acc, cur, wr, wc, fr, fq, lds, wid, lane); S.done(cur); }
#undef PG8_SA
#undef PG8_SB
#undef PG8_STAGE
#undef PG8_LDA
#undef PG8_LDB
#undef PG8_MMA
#undef PG8_WAIT_V
#undef PG8_WAIT_L
#undef PG8_BAR
#undef PG8_SCHED
}
}

#define XB_TMO      128
#define XB_XCNT(j)  (256  + 64 * (j))
#define XB_XSUB(j)  (1280 + 64 * (j))
#define XB_XGEN(j)  (2304 + 64 * (j))
#define XB_TOP      3328
#define XB_TOPGEN   3392
#define XCD_BAR_WORDS 3456
#define XB_SPIN_CAP (1u << 22)
__device__ __forceinline__ unsigned xb_ld(unsigned* p)              { return __hip_atomic_load(p, __ATOMIC_RELAXED, __HIP_MEMORY_SCOPE_AGENT); }
__device__ __forceinline__ unsigned xb_add(unsigned* p, unsigned v) { return __hip_atomic_fetch_add(p, v, __ATOMIC_RELAXED, __HIP_MEMORY_SCOPE_AGENT); }
__device__ __forceinline__ unsigned xb_xcc_id() { return (unsigned)__builtin_amdgcn_s_getreg((3 << 11) | 20) & 0xFu; }
#define XB_SPIN(cond, bar) do { unsigned _sp = 0; while (cond) { __builtin_amdgcn_s_sleep(1); \
    if ((++_sp & 255u) == 0u) { if (xb_ld(&(bar)[XB_TMO])) break; if (_sp > XB_SPIN_CAP) { atomicAdd(&(bar)[XB_TMO], 1u); break; } } } } while (0)
struct XcdBarrier { unsigned* bar; unsigned x; volatile LAS unsigned* st; };
__device__ __forceinline__ XcdBarrier xcd_barrier_post(unsigned* bar, volatile LAS unsigned* st) {
    XcdBarrier b; b.bar = bar; b.x = xb_xcc_id(); b.st = st;
    if (threadIdx.x == 0) (void)xb_add(&bar[XB_XCNT(b.x)], 1u);
    return b;
}
__device__ __forceinline__ void xcd_barrier_complete(unsigned* bar, unsigned x, unsigned& nloc, unsigned& nx) {
    const unsigned G = gridDim.x * gridDim.y * gridDim.z;
    unsigned sum, cnt, mine, sp = 0u;
    for (;;) {
        sum = 0u; cnt = 0u; mine = 0u;
#pragma unroll
        for (unsigned j = 0; j < 16; ++j) { const unsigned c = xb_ld(&bar[XB_XCNT(j)]); sum += c; cnt += (c > 0u) ? 1u : 0u; mine = (j == x) ? c : mine; }
        if (sum == G) break;
        __builtin_amdgcn_s_sleep(1);
        if ((++sp & 255u) == 0u) { if (xb_ld(&bar[XB_TMO])) break; if (sp > XB_SPIN_CAP) { atomicAdd(&bar[XB_TMO], 1u); break; } }
    }
    nloc = mine > 0u ? mine : 1u; nx = cnt > 0u ? cnt : 1u;
}
__device__ __forceinline__ void xcd_barrier(const XcdBarrier& b) {
    asm volatile("s_waitcnt vmcnt(0)" ::: "memory");
    __syncthreads();
    if (threadIdx.x == 0) {
        unsigned* bar = b.bar;
        __builtin_amdgcn_s_waitcnt(0);
        unsigned nloc = b.st[0], nx = b.st[1];
        if (nloc == 0u) { xcd_barrier_complete(bar, b.x, nloc, nx); b.st[0] = nloc; b.st[1] = nx; }
        const unsigned old = xb_add(&bar[XB_XSUB(b.x)], 1u);
        const unsigned gen = old / nloc;
        if (old + 1u == (gen + 1u) * nloc) {
            __builtin_amdgcn_fence(__ATOMIC_RELEASE, "agent");
            asm volatile("s_waitcnt vmcnt(0)" ::: "memory");
            const unsigned og = xb_add(&bar[XB_TOP], 1u);
            const unsigned tg = og / nx;
            if (og + 1u == (tg + 1u) * nx) xb_add(&bar[XB_TOPGEN], 1u);
            else XB_SPIN(xb_ld(&bar[XB_TOPGEN]) == tg, bar);
            __builtin_amdgcn_fence(__ATOMIC_ACQUIRE, "agent");
            xb_add(&bar[XB_XGEN(b.x)], 1u);
            asm volatile("s_waitcnt vmcnt(0)" ::: "memory");
        } else {
            XB_SPIN(xb_ld(&bar[XB_XGEN(b.x)]) == gen, bar);
            __builtin_amdgcn_fence(__ATOMIC_ACQUIRE, "agent");
            asm volatile("s_waitcnt vmcnt(0)" ::: "memory");
        }
    }
    __syncthreads();
}

constexpr int NWAVES = 8, NTHR = NWAVES * 64;
constexpr int RING_BYTES = 131072, MISC_OFF = RING_BYTES, AUX_OFF = MISC_OFF + 256, LDS_BYTES = 147456;
constexpr size_t WS_MODP = WS_MOD + 64 * 1024;
constexpr int CW_BAR = 1024;
constexpr int MAX_LAUNCH = 8;
constexpr size_t CTL_ZERO_BYTES = (size_t)(CW_BAR + MAX_LAUNCH * XCD_BAR_WORDS) * 4;
#define LDS_WAIT() asm volatile("s_waitcnt lgkmcnt(0)" ::: "memory")

struct Args { const float* in[20]; float* out; unsigned char* ws; int ph_lo, ph_hi, li, pad; };
enum { I_X = 0, I_C, I_WADA, I_BADA, I_N1PRE, I_N1POST, I_WIN, I_CONVW, I_CONVB, I_DTB, I_ALOG, I_DSKIP, I_SSMN, I_RELB, I_ATTN, I_WOUT, I_N2PRE, I_N2POST, I_W1, I_W2 };

template <int MODE> __device__ __forceinline__ void p0_transpose_item(const float* W, int K, int N, h16* WT, LAS float* scr, int item, int nblk, int lane) {
    const int kb = item / nblk, nb = item % nblk, k0 = 64 * kb, n0 = 32 * nb;
    const int sc = MODE ? win_src(n0 + (lane & 31)) : n0 + (lane & 31);
#pragma unroll 8
    for (int i = 0; i < 32; ++i) { const int kk = 2 * i + (lane >> 5); scr[kk * 33 + (lane & 31)] = sc >= 0 ? W[(size_t)(k0 + kk) * N + sc] : 0.f; }
    LDS_WAIT(); asm volatile("" ::: "memory");
    const int c = lane & 7;
#pragma unroll
    for (int j = 0; j < 4; ++j) { const int n = (lane >> 3) + 8 * j; const LAS float* s = scr + (8 * c) * 33 + n;
        u32x4 o; o.x = pk_h2(s[0 * 33], s[1 * 33]); o.y = pk_h2(s[2 * 33], s[3 * 33]); o.z = pk_h2(s[4 * 33], s[5 * 33]); o.w = pk_h2(s[6 * 33], s[7 * 33]);
        *(u32x4*)(WT + (size_t)(n0 + n) * K + k0 + 8 * c) = o; }
    LDS_WAIT(); asm volatile("" ::: "memory");
}

__global__ void __launch_bounds__(NTHR, 2) mk_fwd(Args args) {
    extern __shared__ __attribute__((aligned(16))) unsigned char lds_raw[];
    LAS unsigned char* lds = (LAS unsigned char*)lds_raw;
    volatile LAS unsigned* MISC = (volatile LAS unsigned*)(lds + MISC_OFF);
    const int tid = threadIdx.x, lane = tid & 63, wave = __builtin_amdgcn_readfirstlane(tid >> 6);
    const int G = gridDim.x, bx = blockIdx.x, gw = bx * NWAVES + wave, NGW = G * NWAVES;
    unsigned char* ws = args.ws;
    unsigned* ctl = (unsigned*)(ws + WS_CTL);
    const float* x = args.in[I_X]; float* out = args.out;
    float* MOD = (float*)(ws + WS_MOD); float* MODP = (float*)(ws + WS_MODP); float* PF32 = (float*)(ws + WS_PF32);
    h16* WIN = (h16*)(ws + WS_WIN); h16* WOUT = (h16*)(ws + WS_WOUT); h16* W1 = (h16*)(ws + WS_W1); h16* W2 = (h16*)(ws + WS_W2);
    h16* XN = (h16*)(ws + WS_XN); h16* PROJ = (h16*)(ws + WS_PROJ); h16* MIX = (h16*)(ws + WS_MIX);
    float* MIXO = (float*)(ws + WS_MIXO); h16* HB = (h16*)(ws + WS_H); float* FB = (float*)(ws + WS_F);
    if (tid < 64) MISC[tid] = 0u;
    __syncthreads();
    XcdBarrier bar = xcd_barrier_post(ctl + CW_BAR + args.li * XCD_BAR_WORDS, MISC + 8);
    const int lo = args.ph_lo, hi = args.ph_hi;
#define IN(k) (lo <= (k) && (k) < hi)
#define SEAM(k) do { if (IN(k) && IN((k) + 1)) xcd_barrier(bar); } while (0)

    if (IN(0)) {
        LAS float* scr = (LAS float*)(lds + wave * 16384);
        constexpr int I_IN = 16 * 96, I_O = 16 * 32, I_1 = 16 * 128, I_2 = 64 * 32, I_M = 96 * 16, NITEMS = I_IN + I_O + I_1 + I_2 + I_M;
        for (int it = gw; it < NITEMS; it += NGW) {
            int r = it;
            if (r < I_IN) { p0_transpose_item<1>(args.in[I_WIN], D, 2896, WIN, scr, r, 96, lane); continue; } r -= I_IN;
            if (r < I_O) { p0_transpose_item<0>(args.in[I_WOUT], D, D, WOUT, scr, r, 32, lane); continue; } r -= I_O;
            if (r < I_1) { p0_transpose_item<0>(args.in[I_W1], D, FF, W1, scr, r, 128, lane); continue; } r -= I_1;
            if (r < I_2) { p0_transpose_item<0>(args.in[I_W2], FF, D, W2, scr, r, 32, lane); continue; } r -= I_2;
            const int cg = r % 96, ks = r / 96, jj = cg * 64 + lane, k0 = ks * 64;
            const float s0 = silu_f(args.in[I_C][k0 + lane]), s1 = silu_f(args.in[I_C][D + k0 + lane]);
            const float* wp = args.in[I_WADA] + (size_t)k0 * (6 * D) + jj; float a0 = 0.f, a1 = 0.f;
#pragma unroll 16
            for (int kk = 0; kk < 64; ++kk) { const float w = wp[(size_t)kk * (6 * D)]; a0 += __shfl(s0, kk) * w; a1 += __shfl(s1, kk) * w; }
            MODP[(size_t)(ks * 2 + 0) * (6 * D) + jj] = a0; MODP[(size_t)(ks * 2 + 1) * (6 * D) + jj] = a1;
        }
    }
    SEAM(0);
    if (IN(1)) {
        for (int i = bx * NTHR + tid; i < NB * 6 * D; i += G * NTHR) { const int b = i / (6 * D), jj = i % (6 * D); float a = args.in[I_BADA][jj];
#pragma unroll
            for (int ks = 0; ks < 16; ++ks) a += MODP[(size_t)(ks * 2 + b) * (6 * D) + jj];
            MOD[i] = a; }
        LAS float* mv = (LAS float*)lds;
        for (int i = tid; i < NB * 2 * D; i += NTHR) { const int b = i / (2 * D), jj = i % (2 * D); float a = args.in[I_BADA][jj];
#pragma unroll
            for (int ks = 0; ks < 16; ++ks) a += MODP[(size_t)(ks * 2 + b) * (6 * D) + jj];
            mv[i] = a; }
        __syncthreads();
        const float* g1 = args.in[I_N1PRE];
        for (int m = gw; m < M; m += NGW) {
            const int b = m / T; const f32x4* xr = (const f32x4*)(x + (size_t)m * D) + lane; f32x4 v[4]; float ss = 0.f;
#pragma unroll
            for (int j = 0; j < 4; ++j) { v[j] = xr[64 * j]; ss += (v[j].x * v[j].x + v[j].y * v[j].y) + (v[j].z * v[j].z + v[j].w * v[j].w); }
            const float rstd = rsqrtf(wave_sum(ss) * (1.f / D) + EPS);
            u32x2* o8 = (u32x2*)(XN + (size_t)m * D) + lane;
#pragma unroll
            for (int j = 0; j < 4; ++j) { const int k = 4 * lane + 256 * j; const f32x4 gg = *(const f32x4*)(g1 + k);
                const f32x4 sh = *(const LAS f32x4*)(mv + b * 2 * D + k), sc = *(const LAS f32x4*)(mv + b * 2 * D + D + k);
                const f32x4 r = v[j] * rstd * gg * (sc + 1.f) + sh; u32x2 w; w.x = pk_h2(r.x, r.y); w.y = pk_h2(r.z, r.w); o8[64 * j] = w; }
        }
        __syncthreads();
    }
    SEAM(1);
    if (IN(2)) {
        pg8::Gemm g{XN, WIN, M, NPROJ, D}; pg8::StaticOrder S; S.init(M, NPROJ, G, bx);
        pg8::EpiH16<0, true> E{PROJ, NPROJ, PF32};
        pg8::gemm_phase<pg8::EpiH16<0, true>, pg8::StaticOrder, true, true>(lds, g, S, E);
    }
    SEAM(2);
    if (IN(3)) {
        LAS h16* raw = (LAS h16*)(lds + wave * 16384);
        constexpr int N_CONV = NB * 128 * 16, N_SCAN = NB * 32 * 8;
        for (int it = gw; it < N_CONV + N_SCAN; it += NGW) {
            if (it < N_CONV) {
                const int cb = it & 15, tb = (it >> 4) & 127, b = it >> 11, t0 = tb * 64; const size_t m0 = (size_t)b * T + t0;
#pragma unroll
                for (int i = 0; i < 9; ++i) { const int row = (lane >> 3) + 8 * i, ch = lane & 7; u32x4 v = {0u, 0u, 0u, 0u};
                    if (row < 67 && t0 - 3 + row >= 0) v = *(const u32x4*)(PROJ + (m0 - 3 + row) * NPROJ + C_XBC + cb * 64 + ch * 8);
                    *(LAS u32x4*)(raw + row * 64 + ch * 8) = v; }
                LDS_WAIT(); asm volatile("" ::: "memory");
                const int chn = cb * 64 + lane;
                const float w0 = args.in[I_CONVW][chn], w1 = args.in[I_CONVW][1024 + chn], w2 = args.in[I_CONVW][2048 + chn], w3 = args.in[I_CONVW][3072 + chn], cbias = args.in[I_CONVB][chn];
                float r0 = (float)raw[lane], r1 = (float)raw[64 + lane], r2 = (float)raw[128 + lane];
                unsigned yp[32];
#pragma unroll
                for (int t = 0; t < 64; t += 2) {
                    const float r3 = (float)raw[(t + 3) * 64 + lane], r4 = (float)raw[(t + 4) * 64 + lane];
                    const float a0 = cbias + w0 * r0 + w1 * r1 + w2 * r2 + w3 * r3, a1 = cbias + w0 * r1 + w1 * r2 + w2 * r3 + w3 * r4;
                    const float y0 = a0 * __builtin_amdgcn_rcpf(1.f + __expf(-a0)), y1 = a1 * __builtin_amdgcn_rcpf(1.f + __expf(-a1));
                    yp[t >> 1] = pk_h2(y0, y1);
                    raw[t * 64 + lane] = (h16)y0; raw[(t + 1) * 64 + lane] = (h16)y1;
                    r0 = r2; r1 = r3; r2 = r4;
                }
                LDS_WAIT(); asm volatile("" ::: "memory");
                h16* xc = (h16*)((unsigned char*)out + DO_XC);
#pragma unroll
                for (int i = 0; i < 8; ++i) { const int row = (lane >> 3) + 8 * i, ch = lane & 7;
                    *(u32x4*)(xc + (m0 + row) * 1024 + cb * 64 + ch * 8) = *(const LAS u32x4*)(raw + row * 64 + ch * 8); }
                if (cb < 12) {
                    h16* dst = cb < 8 ? (h16*)((unsigned char*)out + DO_XST) + ((size_t)(b * 8 + cb) * 64 + lane) * T + t0
                                      : (h16*)((unsigned char*)out + DO_BT) + ((size_t)(b * 2 + ((cb - 8) >> 1)) * 128 + ((cb - 8) & 1) * 64 + lane) * T + t0;
#pragma unroll
                    for (int i = 0; i < 8; ++i) { u32x4 v = {yp[4 * i], yp[4 * i + 1], yp[4 * i + 2], yp[4 * i + 3]}; *(u32x4*)(dst + 8 * i) = v; }
                }
                LDS_WAIT(); asm volatile("" ::: "memory");
            } else {
                const int r = it - N_CONV, h = r & 7, c = (r >> 3) & 31, b = r >> 8; const size_t m = (size_t)b * T + c * 256 + 4 * lane;
                const float a = -__expf(args.in[I_ALOG][h]), bias = args.in[I_DTB][h];
                f32x4 dt, cs; float run = 0.f;
#pragma unroll
                for (int j = 0; j < 4; ++j) { dt[j] = softplus_f(PF32[(m + j) * 16 + h] + bias); run += a * dt[j]; cs[j] = run; }
                float incl = run;
#pragma unroll
                for (int o = 1; o < 64; o <<= 1) { const float u = __shfl_up(incl, o); if (lane >= o) incl += u; }
                const float excl = incl - run;
                float* DTp = (float*)(ws + WS_DT); float* ACSp = (float*)(ws + WS_ACS); const size_t o4 = (size_t)(b * 8 + h) * T + c * 256 + 4 * lane;
                *(f32x4*)(DTp + o4) = dt; *(f32x4*)(ACSp + o4) = cs + excl;
            }
        }
    }
    SEAM(3);
    if (IN(4)) {
        LAS float* wtab = (LAS float*)lds;
        const h16* XST = (const h16*)((unsigned char*)out + DO_XST); const h16* BT = (const h16*)((unsigned char*)out + DO_BT);
        const float* DTp = (const float*)(ws + WS_DT); const float* ACSp = (const float*)(ws + WS_ACS); float* ST = (float*)(ws + WS_STATES);
        const int r = lane & 31, hh = lane >> 5, pt = wave & 1, ntile = wave >> 1;
        for (int u = bx; u < NB * 32 * 8; u += G) {
            const int h = u & 7, c = (u >> 3) & 31, b = u >> 8, g = h >> 2; const size_t tb = (size_t)(b * 8 + h) * T + c * 256;
            if (tid < 256) wtab[tid] = DTp[tb + tid] * __expf(ACSp[tb + 255] - ACSp[tb + tid]);
            __syncthreads();
            f32x16 acc;
#pragma unroll
            for (int i = 0; i < 16; ++i) acc[i] = 0.f;
            const h16* ap = XST + ((size_t)(b * 8 + h) * 64 + pt * 32 + r) * T + c * 256 + 8 * hh;
            const h16* bp = BT + ((size_t)(b * 2 + g) * 128 + ntile * 32 + r) * T + c * 256 + 8 * hh;
#pragma unroll 4
            for (int ks = 0; ks < 16; ++ks) {
                const h16x8 A = *(const h16x8*)(ap + 16 * ks), Bv = *(const h16x8*)(bp + 16 * ks);
                const f32x4 wa = *(const LAS f32x4*)(wtab + 16 * ks + 8 * hh), wb = *(const LAS f32x4*)(wtab + 16 * ks + 8 * hh + 4);
                h16x8 Bs;
#pragma unroll
                for (int j = 0; j < 4; ++j) { Bs[j] = (h16)((float)Bv[j] * wa[j]); Bs[4 + j] = (h16)((float)Bv[4 + j] * wb[j]); }
                acc = __builtin_amdgcn_mfma_f32_32x32x16_f16(A, Bs, acc, 0, 0, 0);
            }
            float* sp = ST + ((size_t)((b * 32 + c) * 8 + h) * 64 + pt * 32) * 128 + ntile * 32 + r;
#pragma unroll
            for (int i = 0; i < 16; ++i) sp[(size_t)((i & 3) + 8 * (i >> 2) + 4 * hh) * 128] = acc[i];
            __syncthreads();
        }
    }
    SEAM(4);
    if (IN(5)) {
        const float* ACSp = (const float*)(ws + WS_ACS); const float* ST = (const float*)(ws + WS_STATES); h16* PV = (h16*)(ws + WS_PREV);
        for (int e = bx * NTHR + tid; e < NB * 8 * 64 * 128; e += G * NTHR) {
            const int pn = e & 8191, h = (e >> 13) & 7, b = e >> 16; float hs = 0.f;
            float sv[32];
#pragma unroll
            for (int c = 0; c < 32; ++c) sv[c] = ST[(size_t)((b * 32 + c) * 8 + h) * 8192 + pn];
#pragma unroll
            for (int c = 0; c < 32; ++c) { PV[(size_t)((b * 32 + c) * 8 + h) * 8192 + pn] = (h16)hs; hs = hs * __expf(ACSp[(size_t)(b * 8 + h) * T + c * 256 + 255]) + sv[c]; }
        }
    }
    SEAM(5);
    if (IN(6)) {
        LAS float* acs_tab = (LAS float*)lds; LAS float* dt_tab = acs_tab + 2048; LAS float* part = dt_tab + 2048;
        const h16* XC = (const h16*)((unsigned char*)out + DO_XC); const h16* XST = (const h16*)((unsigned char*)out + DO_XST);
        const float* DTp = (const float*)(ws + WS_DT); const float* ACSp = (const float*)(ws + WS_ACS); const h16* PV = (const h16*)(ws + WS_PREV);
        const int r = lane & 31, hh = lane >> 5, h = wave, g = h >> 2; const float dsk = args.in[I_DSKIP][h];
        for (int i = 0;; ++i) {
            const int j = i * G + bx; if (j >= NB * 32 * 8) break;
            const int bc = j >> 3, lbr = j & 7, lb = (i & 1) ? 7 - lbr : lbr, b = bc >> 5, c = bc & 31, t0 = c * 256;
            for (int k = tid; k < 2048; k += NTHR) { const size_t o = (size_t)(b * 8 + (k >> 8)) * T + t0 + (k & 255); acs_tab[k] = ACSp[o]; dt_tab[k] = DTp[o]; }
            __syncthreads();
            const int l = lb * 32 + r; const size_t ml = (size_t)b * T + t0 + l; const float acs_l = acs_tab[h * 256 + l];
            h16x8 Cf[8];
#pragma unroll
            for (int ks = 0; ks < 8; ++ks) Cf[ks] = *(const h16x8*)(XC + ml * 1024 + 768 + g * 128 + 16 * ks + 8 * hh);
            f32x16 Y[2];
#pragma unroll
            for (int q = 0; q < 16; ++q) { Y[0][q] = 0.f; Y[1][q] = 0.f; }
            const h16* xst = XST + ((size_t)(b * 8 + h) * 64 + r) * T + t0 + 4 * hh;
            for (int sb = 0; sb <= lb; ++sb) {
                const size_t ms = (size_t)b * T + t0 + sb * 32 + r;
                f32x16 Dv;
#pragma unroll
                for (int q = 0; q < 16; ++q) Dv[q] = 0.f;
#pragma unroll
                for (int ks = 0; ks < 8; ++ks) { const h16x8 Bf = *(const h16x8*)(XC + ms * 1024 + 512 + g * 128 + 16 * ks + 8 * hh); Dv = __builtin_amdgcn_mfma_f32_32x32x16_f16(Bf, Cf[ks], Dv, 0, 0, 0); }
                h16x8 Mf[2];
#pragma unroll
                for (int q = 0; q < 4; ++q) { const int sl = sb * 32 + 8 * q + 4 * hh;
                    const f32x4 as = *(const LAS f32x4*)(acs_tab + h * 256 + sl), ds = *(const LAS f32x4*)(dt_tab + h * 256 + sl);
#pragma unroll
                    for (int e = 0; e < 4; ++e) { float v = Dv[4 * q + e] * __expf(acs_l - as[e]) * ds[e]; if (sl + e > l) v = 0.f; Mf[q >> 1][(q & 1) * 4 + e] = (h16)v; } }
#pragma unroll
                for (int s2 = 0; s2 < 2; ++s2)
#pragma unroll
                    for (int pt = 0; pt < 2; ++pt) { const h16* ap = xst + (size_t)(pt * 32) * T + sb * 32 + 16 * s2;
                        const h16x4 lo = *(const h16x4*)ap, hi = *(const h16x4*)(ap + 8);
                        const h16x8 A = {lo[0], lo[1], lo[2], lo[3], hi[0], hi[1], hi[2], hi[3]};
                        Y[pt] = __builtin_amdgcn_mfma_f32_32x32x16_f16(A, Mf[s2], Y[pt], 0, 0, 0); }
            }
            {
                f32x16 O[2];
#pragma unroll
                for (int q = 0; q < 16; ++q) { O[0][q] = 0.f; O[1][q] = 0.f; }
                const h16* pv = PV + ((size_t)((b * 32 + c) * 8 + h) * 64 + r) * 128 + 8 * hh;
#pragma unroll
                for (int ks = 0; ks < 8; ++ks)
#pragma unroll
                    for (int pt = 0; pt < 2; ++pt) { const h16x8 A = *(const h16x8*)(pv + (size_t)(pt * 32) * 128 + 16 * ks); O[pt] = __builtin_amdgcn_mfma_f32_32x32x16_f16(A, Cf[ks], O[pt], 0, 0, 0); }
                const float el = __expf(acs_l);
#pragma unroll
                for (int q = 0; q < 16; ++q) { Y[0][q] += O[0][q] * el; Y[1][q] += O[1][q] * el; }
            }
            float ss = 0.f;
#pragma unroll
            for (int pt = 0; pt < 2; ++pt)
#pragma unroll
                for (int q = 0; q < 4; ++q) { const int p0 = h * 64 + pt * 32 + 8 * q + 4 * hh;
                    const h16x4 xv = *(const h16x4*)(XC + ml * 1024 + p0), zv = *(const h16x4*)(PROJ + ml * NPROJ + C_Z + p0);
#pragma unroll
                    for (int e = 0; e < 4; ++e) { const float z = (float)zv[e]; const float u = (Y[pt][4 * q + e] + dsk * (float)xv[e]) * (z * __builtin_amdgcn_rcpf(1.f + __expf(-z))); Y[pt][4 * q + e] = u; ss += u * u; } }
            ss += __shfl_xor(ss, 32);
            if (hh == 0) part[h * 32 + r] = ss;
            __syncthreads();
            float tot = 0.f;
#pragma unroll
            for (int w = 0; w < 8; ++w) tot += part[w * 32 + r];
            const float rstd = rsqrtf(tot * (1.f / 512.f) + EPS);
#pragma unroll
            for (int pt = 0; pt < 2; ++pt)
#pragma unroll
                for (int q = 0; q < 4; ++q) { const int p0 = h * 64 + pt * 32 + 8 * q + 4 * hh; const f32x4 wv = *(const f32x4*)(args.in[I_SSMN] + p0);
                    u32x2 o; o.x = pk_h2(Y[pt][4 * q] * rstd * wv[0], Y[pt][4 * q + 1] * rstd * wv[1]); o.y = pk_h2(Y[pt][4 * q + 2] * rstd * wv[2], Y[pt][4 * q + 3] * rstd * wv[3]);
                    *(u32x2*)(MIX + ml * D + p0) = o; }
            __syncthreads();
        }
    }
    SEAM(6);
    if (IN(7)) {
        float* slab = (float*)((unsigned char*)out + (size_t)bx * (8 * T * 4));
        LAS unsigned* hist = (LAS unsigned*)(lds + wave * 8448);
        unsigned short* IDX = (unsigned short*)(ws + WS_IDX);
        const int r = lane & 31, hh = lane >> 5;
        for (int i = 0;; ++i) {
            const int rho = i * G + ((i & 1) ? G - 1 - bx : bx); if (rho >= NB * (T / 8)) break;
            const int b = rho & 1, tq0 = 8 * (T / 8 - 1 - (rho >> 1));
            const size_t mq0 = (size_t)b * T + tq0;
            const int tq = tq0 + wave, n = tq + 1;
            unsigned short* orow = IDX + (mq0 + wave) * TOPK;
            if (tq0 + 8 <= TOPK) {
#pragma unroll
                for (int e = 0; e < 4; ++e) { const int j = 4 * lane + e; orow[j] = (unsigned short)(j < n ? j : 0); }
                continue;
            }
            {
                h16x8 Af[2][4]; float wq[2][2][8];
#pragma unroll
                for (int tl = 0; tl < 2; ++tl) {
                    const int hd = (r & 3) + 4 * ((r >> 3) & 1), ql = 4 * tl + ((r >> 2) & 1) + 2 * (r >> 4);
#pragma unroll
                    for (int ks = 0; ks < 4; ++ks) Af[tl][ks] = *(const h16x8*)(PROJ + (mq0 + ql) * NPROJ + C_QI + hd * 64 + 16 * ks + 8 * hh);
#pragma unroll
                    for (int hf = 0; hf < 2; ++hf) { const float* wp = PF32 + (mq0 + 4 * tl + hh + 2 * hf) * 16 + 8;
#pragma unroll
                        for (int e = 0; e < 8; ++e) wq[tl][hf][e] = wp[e] * (0.35355339059327373f * 0.125f); }
                }
                const int ntile = (tq0 + 8 + 31) >> 5;
                for (int kt = wave; kt < ntile; kt += NWAVES) {
                    const h16* kp = PROJ + ((size_t)b * T + kt * 32 + r) * NPROJ + C_KI + 8 * hh;
                    h16x8 Bf[4];
#pragma unroll
                    for (int ks = 0; ks < 4; ++ks) Bf[ks] = *(const h16x8*)(kp + 16 * ks);
#pragma unroll
                    for (int tl = 0; tl < 2; ++tl) {
                        f32x16 Dv;
#pragma unroll
                        for (int q = 0; q < 16; ++q) Dv[q] = 0.f;
#pragma unroll
                        for (int ks = 0; ks < 4; ++ks) Dv = __builtin_amdgcn_mfma_f32_32x32x16_f16(Af[tl][ks], Bf[ks], Dv, 0, 0, 0);
#pragma unroll
                        for (int hf = 0; hf < 2; ++hf) { float sc = 0.f;
#pragma unroll
                            for (int e = 0; e < 8; ++e) sc += wq[tl][hf][e] * fmaxf(Dv[8 * hf + e], 0.f);
                            slab[(size_t)(4 * tl + hh + 2 * hf) * T + kt * 32 + r] = sc; }
                    }
                }
            }
            asm volatile("s_waitcnt vmcnt(0)" ::: "memory");
            __syncthreads();
            __builtin_amdgcn_fence(__ATOMIC_ACQUIRE, "agent");
            asm volatile("s_waitcnt vmcnt(0)" ::: "memory");
            {
                const float* row = slab + (size_t)wave * T;
                unsigned prefix = 0u, pmask = 0u; int need = TOPK;
#pragma unroll 1
                for (int lvl = 0; lvl < 3; ++lvl) {
                    const int sh = lvl == 0 ? 21 : (lvl == 1 ? 10 : 0); const unsigned bm = lvl == 2 ? 0x3ffu : 0x7ffu;
                    for (int k = lane; k < 2112; k += 64) hist[k] = 0u;
                    LDS_WAIT(); asm volatile("" ::: "memory");
                    for (int i0 = 0; i0 < n; i0 += 256) {
                        const f32x4 v = *(const f32x4*)(row + i0 + 4 * lane);
#pragma unroll
                        for (int e = 0; e < 4; ++e) { const unsigned key = fkey(v[e]); const unsigned bin = (key >> sh) & bm;
                            if (i0 + 4 * lane + e < n && (key & pmask) == prefix) __hip_atomic_fetch_add(&hist[bin + (bin >> 5)], 1u, __ATOMIC_RELAXED, __HIP_MEMORY_SCOPE_WORKGROUP); }
                    }
                    LDS_WAIT(); asm volatile("" ::: "memory");
                    unsigned own = 0u;
#pragma unroll
                    for (int k = 0; k < 32; ++k) own += hist[33 * lane + k];
                    unsigned suf = own;
#pragma unroll
                    for (int o = 1; o < 64; o <<= 1) { const unsigned u = __shfl_down(suf, o); if (lane + o < 64) suf += u; }
                    const unsigned long long mk = __ballot(suf >= (unsigned)need);
                    const int Ls = 63 - __builtin_clzll(mk);
                    unsigned cum = suf - own; int Bsel = 0; unsigned above = 0u; bool found = false;
#pragma unroll
                    for (int k = 31; k >= 0; --k) { const unsigned c = hist[33 * lane + k]; if (!found && cum + c >= (unsigned)need) { found = true; Bsel = k; above = cum; } cum += c; }
                    const int Bl = __shfl(Bsel, Ls); const unsigned ab = __shfl(above, Ls);
                    const unsigned bin = (unsigned)(32 * Ls + Bl);
                    prefix |= bin << sh; pmask |= bm << sh; need -= (int)ab;
                }
                const unsigned Kt = prefix; unsigned base_gt = 0u, base_tie = 0u;
                for (int i0 = 0; i0 < n; i0 += 256) {
                    const f32x4 v = *(const f32x4*)(row + i0 + 4 * lane);
                    unsigned kk[4]; unsigned cg = 0u, ct = 0u;
#pragma unroll
                    for (int e = 0; e < 4; ++e) { kk[e] = (i0 + 4 * lane + e < n) ? fkey(v[e]) : 0u; cg += (kk[e] > Kt); ct += (kk[e] == Kt); }
                    unsigned pk = (ct << 16) | cg, inc = pk;
#pragma unroll
                    for (int o = 1; o < 64; o <<= 1) { const unsigned u = __shfl_up(inc, o); if (lane >= o) inc += u; }
                    const unsigned exc = inc - pk, tot = __shfl(inc, 63);
                    unsigned gt_before = base_gt + (exc & 0xffffu), tie_before = base_tie + (exc >> 16);
                    unsigned pos = gt_before + (tie_before < (unsigned)need ? tie_before : (unsigned)need);
#pragma unroll
                    for (int e = 0; e < 4; ++e) { bool s = kk[e] > Kt; if (kk[e] == Kt) { s = tie_before < (unsigned)need; ++tie_before; }
                        if (s) { orow[pos] = (unsigned short)(i0 + 4 * lane + e); ++pos; } }
                    base_gt += tot & 0xffffu; base_tie += tot >> 16;
                }
            }
            __syncthreads();
        }
    }
    SEAM(7);
    if (IN(8)) {
        constexpr int P_ROW = 528, V_ROW = 272, WSZ = 8 * P_ROW + 32 * V_ROW + 512;
        LAS unsigned char* wl = lds + wave * WSZ;
        LAS unsigned char* Pl = wl; LAS unsigned char* Vl = wl + 8 * P_ROW; LAS unsigned short* idxl = (LAS unsigned short*)(wl + 8 * P_ROW + 32 * V_ROW);
        LAS float* bias_tab = (LAS float*)(lds + NWAVES * WSZ); LAS unsigned char* zrow = lds + NWAVES * WSZ + 4096;
        const unsigned short* IDX = (const unsigned short*)(ws + WS_IDX);
        for (int k = tid; k < 1024; k += NTHR) bias_tab[k] = args.in[I_RELB][t5_bucket(k >> 3) * 8 + (k & 7)];
        for (int k = tid; k < P_ROW / 4; k += NTHR) ((LAS unsigned*)zrow)[k] = 0u;
        __syncthreads();
        const int kq = lane >> 4, l16 = lane & 15, hd = l16 & 7;
        const LAS unsigned char* prow = l16 < 8 ? Pl + l16 * P_ROW : zrow;
        for (int m = gw; m < M; m += NGW) {
            const int b = m / T, t = m % T, cnt = (t + 1 < TOPK) ? t + 1 : TOPK;
            *(LAS u32x2*)(idxl + 4 * lane) = *(const u32x2*)(IDX + (size_t)m * TOPK + 4 * lane);
            h16x8 Qf[4];
#pragma unroll
            for (int ks = 0; ks < 4; ++ks) {
                h16x8 q = *(const h16x8*)(PROJ + (size_t)m * NPROJ + C_Q + hd * 64 + 32 * (ks & 1) + 8 * kq);
                const bool ok = l16 < 8 && (l16 >> 2) == (ks >> 1);
#pragma unroll
                for (int j = 0; j < 8; ++j) Qf[ks][j] = ok ? q[j] * (h16)0.125f : (h16)0.f;
            }
            LDS_WAIT(); asm volatile("" ::: "memory");
            const h16* kvb = PROJ + (size_t)b * T * NPROJ;
            f32x4 S[16];
#pragma unroll
            for (int kt = 0; kt < 16; ++kt) {
                const int s = idxl[16 * kt + l16]; const h16* kp = kvb + (size_t)s * NPROJ + C_K + 8 * kq;
                f32x4 a = {0.f, 0.f, 0.f, 0.f};
#pragma unroll
                for (int ks = 0; ks < 4; ++ks) a = __builtin_amdgcn_mfma_f32_16x16x32_f16(*(const h16x8*)(kp + 32 * ks), Qf[ks], a, 0, 0, 0);
                S[kt] = a;
            }
            float mx = -1e30f;
#pragma unroll
            for (int kt = 0; kt < 16; ++kt) {
                const u32x2 iv = *(const LAS u32x2*)(idxl + 16 * kt + 4 * kq);
#pragma unroll
                for (int i = 0; i < 4; ++i) { const int s = (int)((i & 2 ? iv.y : iv.x) >> (16 * (i & 1))) & 0xffff; int dd = t - s; dd = dd < 0 ? 0 : (dd > 127 ? 127 : dd);
                    float lg = S[kt][i] + bias_tab[dd * 8 + hd]; if (16 * kt + 4 * kq + i >= cnt) lg = -1e30f; S[kt][i] = lg; mx = fmaxf(mx, lg); }
            }
            mx = fmaxf(mx, __shfl_xor(mx, 16)); mx = fmaxf(mx, __shfl_xor(mx, 32));
            float lsum = 0.f;
#pragma unroll
            for (int kt = 0; kt < 16; ++kt) {
                float p[4];
#pragma unroll
                for (int i = 0; i < 4; ++i) { p[i] = __expf(S[kt][i] - mx); lsum += p[i]; }
                if (l16 < 8) { u32x2 w; w.x = pk_h2(p[0], p[1]); w.y = pk_h2(p[2], p[3]); *(LAS u32x2*)(Pl + l16 * P_ROW + (16 * kt + 4 * kq) * 2) = w; }
            }
            lsum += __shfl_xor(lsum, 16); lsum += __shfl_xor(lsum, 32);
            f32x4 O[2][4];
#pragma unroll
            for (int g = 0; g < 2; ++g)
#pragma unroll
                for (int nt = 0; nt < 4; ++nt) O[g][nt] = (f32x4){0.f, 0.f, 0.f, 0.f};
            u32x4 vr[8];
#pragma unroll
            for (int i = 0; i < 8; ++i) { const int s = idxl[kq + 4 * i]; vr[i] = *(const u32x4*)(kvb + (size_t)s * NPROJ + C_V + l16 * 8); }
#pragma unroll 1
            for (int k2 = 0; k2 < 8; ++k2) {
#pragma unroll
                for (int i = 0; i < 8; ++i) *(LAS u32x4*)(Vl + (kq + 4 * i) * V_ROW + l16 * 16) = vr[i];
                if (k2 < 7) {
#pragma unroll
                    for (int i = 0; i < 8; ++i) { const int s = idxl[32 * (k2 + 1) + kq + 4 * i]; vr[i] = *(const u32x4*)(kvb + (size_t)s * NPROJ + C_V + l16 * 8); }
                }
                const h16x8 Pf = *(const LAS h16x8*)(prow + (32 * k2 + 8 * kq) * 2);
#pragma unroll
                for (int g = 0; g < 2; ++g)
#pragma unroll
                    for (int nt = 0; nt < 4; ++nt) {
                        const LAS unsigned char* va = Vl + (8 * kq + (l16 >> 2)) * V_ROW + (g * 64 + 16 * nt + 4 * (l16 & 3)) * 2;
                        typedef short s16x4 __attribute__((ext_vector_type(4)));
                        const s16x4 t0 = __builtin_amdgcn_ds_read_tr16_b64_v4i16((LAS s16x4*)va), t1 = __builtin_amdgcn_ds_read_tr16_b64_v4i16((LAS s16x4*)(va + 4 * V_ROW));
                        const h16x4 f0 = __builtin_bit_cast(h16x4, t0), f1 = __builtin_bit_cast(h16x4, t1);
                        const h16x8 Vf = {f0[0], f0[1], f0[2], f0[3], f1[0], f1[1], f1[2], f1[3]};
                        O[g][nt] = __builtin_amdgcn_mfma_f32_16x16x32_f16(Pf, Vf, O[g][nt], 0, 0, 0);
                    }
            }
            float inv[4];
#pragma unroll
            for (int i = 0; i < 4; ++i) inv[i] = 1.f / __shfl(lsum, (4 * kq + i) & 7);
            float ss = 0.f; f32x4 Y[4];
#pragma unroll
            for (int nt = 0; nt < 4; ++nt) { const f32x4 o = kq == 0 ? O[0][nt] : O[1][nt];
#pragma unroll
                for (int i = 0; i < 4; ++i) { Y[nt][i] = o[i] * inv[i]; ss += Y[nt][i] * Y[nt][i]; } }
            if (kq >= 2) ss = 0.f;
            const float rstd = rsqrtf(wave_sum(ss) * (1.f / 512.f) + EPS);
            if (kq < 2) {
#pragma unroll
                for (int nt = 0; nt < 4; ++nt)
#pragma unroll
                    for (int i = 0; i < 4; ++i) { const int ch = (4 * kq + i) * 64 + 16 * nt + l16; MIX[(size_t)m * D + 512 + ch] = (h16)(Y[nt][i] * rstd * args.in[I_ATTN][ch]); }
            }
        }
    }
    SEAM(8);
    if (IN(9)) {
        pg8::Gemm g{MIX, WOUT, M, D, D}; pg8::StaticOrder S; S.init(M, D, G, bx);
        pg8::EpiF32 E{MIXO, D};
        pg8::gemm_phase<pg8::EpiF32, pg8::StaticOrder, true, true>(lds, g, S, E);
    }
    SEAM(9);
    if (IN(10)) {
        const float* w1p = args.in[I_N1POST]; const float* w2p = args.in[I_N2PRE];
        for (int m = gw; m < M; m += NGW) {
            const int b = m / T; const float* md = MOD + (size_t)b * 6 * D; const f32x4* mr = (const f32x4*)(MIXO + (size_t)m * D) + lane; const f32x4* xr = (const f32x4*)(x + (size_t)m * D) + lane;
            f32x4 v[4]; float ss = 0.f;
#pragma unroll
            for (int j = 0; j < 4; ++j) { v[j] = mr[64 * j]; ss += (v[j].x * v[j].x + v[j].y * v[j].y) + (v[j].z * v[j].z + v[j].w * v[j].w); }
            float rstd = rsqrtf(wave_sum(ss) * (1.f / D) + EPS); ss = 0.f;
            f32x4* orow = (f32x4*)(out + (size_t)m * D) + lane;
#pragma unroll
            for (int j = 0; j < 4; ++j) { const int k = 4 * lane + 256 * j; const f32x4 gt = *(const f32x4*)(md + 2 * D + k), wp = *(const f32x4*)(w1p + k);
                v[j] = xr[64 * j] + gt * (v[j] * rstd * wp); orow[64 * j] = v[j]; ss += (v[j].x * v[j].x + v[j].y * v[j].y) + (v[j].z * v[j].z + v[j].w * v[j].w); }
            rstd = rsqrtf(wave_sum(ss) * (1.f / D) + EPS);
            u32x2* o8 = (u32x2*)(XN + (size_t)m * D) + lane;
#pragma unroll
            for (int j = 0; j < 4; ++j) { const int k = 4 * lane + 256 * j; const f32x4 gg = *(const f32x4*)(w2p + k), sh = *(const f32x4*)(md + 3 * D + k), sc = *(const f32x4*)(md + 4 * D + k);
                const f32x4 r = v[j] * rstd * gg * (sc + 1.f) + sh; u32x2 w; w.x = pk_h2(r.x, r.y); w.y = pk_h2(r.z, r.w); o8[64 * j] = w; }
        }
    }
    SEAM(10);
    if (IN(11)) {
        pg8::Gemm g{XN, W1, M, FF, D}; pg8::StaticOrder S; S.init(M, FF, G, bx);
        pg8::EpiH16<1, false> E{HB, FF, nullptr};
        pg8::gemm_phase<pg8::EpiH16<1, false>, pg8::StaticOrder, true, true>(lds, g, S, E);
    }
    SEAM(11);
    if (IN(12)) {
        pg8::Gemm g{HB, W2, M, D, FF}; pg8::StaticOrder S; S.init(M, D, G, bx);
        pg8::EpiF32 E{FB, D};
        pg8::gemm_phase<pg8::EpiF32, pg8::StaticOrder, true, true>(lds, g, S, E);
    }
    SEAM(12);
    if (IN(13)) {
        const float* w2post = args.in[I_N2POST];
        for (int m = gw; m < M; m += NGW) {
            const int b = m / T; const float* md = MOD + (size_t)b * 6 * D; const f32x4* fr = (const f32x4*)(FB + (size_t)m * D) + lane;
            f32x4 v[4]; float ss = 0.f;
#pragma unroll
            for (int j = 0; j < 4; ++j) { v[j] = fr[64 * j]; ss += (v[j].x * v[j].x + v[j].y * v[j].y) + (v[j].z * v[j].z + v[j].w * v[j].w); }
            const float rstd = rsqrtf(wave_sum(ss) * (1.f / D) + EPS);
            f32x4* orow = (f32x4*)(out + (size_t)m * D) + lane;
#pragma unroll
            for (int j = 0; j < 4; ++j) { const int k = 4 * lane + 256 * j; const f32x4 gt = *(const f32x4*)(md + 5 * D + k), wp = *(const f32x4*)(w2post + k);
                orow[64 * j] = orow[64 * j] + gt * (v[j] * rstd * wp); }
        }
    }
#undef IN
#undef SEAM
}

static int g_grid = 0;
static void mk_launch(Args& a, int lo, int hi, int li, hipStream_t stream) {
    a.ph_lo = lo; a.ph_hi = hi; a.li = li;
    hipLaunchKernelGGL(mk_fwd, dim3(g_grid), dim3(NTHR), LDS_BYTES, stream, a);
}

extern "C" void kernel_launch(void* const* d_in, const int* in_sizes, int n_in, void* d_out, int out_size, void* d_ws, size_t ws_size, hipStream_t stream) {
    const float* x = (const float*)d_in[0]; const float* c = (const float*)d_in[1]; const float* w_ada = (const float*)d_in[2]; const float* b_ada = (const float*)d_in[3];
    const float* norm1_pre = (const float*)d_in[4]; const float* norm1_post = (const float*)d_in[5]; const float* w_in = (const float*)d_in[6];
    const float* conv_w = (const float*)d_in[7]; const float* conv_b = (const float*)d_in[8]; const float* dt_bias = (const float*)d_in[9];
    const float* a_log = (const float*)d_in[10]; const float* d_skip = (const float*)d_in[11]; const float* ssm_norm = (const float*)d_in[12];
    const float* rel_bias = (const float*)d_in[13]; const float* attn_norm = (const float*)d_in[14]; const float* w_out = (const float*)d_in[15];
    const float* norm2_pre = (const float*)d_in[16]; const float* norm2_post = (const float*)d_in[17]; const float* w_mlp_in = (const float*)d_in[18]; const float* w_mlp_out = (const float*)d_in[19];
    unsigned char* ws = (unsigned char*)d_ws; unsigned char* dob = (unsigned char*)d_out; float* out = (float*)d_out;
    float* MOD = (float*)(ws + WS_MOD); float* PF32 = (float*)(ws + WS_PF32);
    h16* WIN = (h16*)(ws + WS_WIN); h16* WOUT = (h16*)(ws + WS_WOUT); h16* W1 = (h16*)(ws + WS_W1); h16* W2 = (h16*)(ws + WS_W2);
    h16* XN = (h16*)(ws + WS_XN); h16* PROJ = (h16*)(ws + WS_PROJ); h16* MIX = (h16*)(ws + WS_MIX); unsigned short* IDX = (unsigned short*)(ws + WS_IDX);
    float* YTMP = (float*)(ws + WS_YTMP); float* DTV = (float*)(ws + WS_DT); float* MIXO = (float*)(ws + WS_MIXO); h16* HB = (h16*)(ws + WS_H); float* FB = (float*)(ws + WS_F);
    h16* XC = (h16*)(dob + DO_XC); float* SLAB = (float*)dob;

    if (g_grid == 0) {
        int dev = 0, cus = 0;
        if (hipGetDevice(&dev) != hipSuccess || hipDeviceGetAttribute(&cus, hipDeviceAttributeMultiprocessorCount, dev) != hipSuccess) { fprintf(stderr, "kernel_launch: device query failed\n"); g_grid = -1; return; }
        if (hipFuncSetAttribute((const void*)mk_fwd, hipFuncAttributeMaxDynamicSharedMemorySize, LDS_BYTES) != hipSuccess) { fprintf(stderr, "kernel_launch: hipFuncSetAttribute failed\n"); g_grid = -1; return; }
        g_grid = cus;
        if (ws_size < 256 * MiB) fprintf(stderr, "kernel_launch: workspace too small: %zu\n", ws_size);
    }
    if (g_grid < 0) return;
    (void)hipMemsetAsync(ws + WS_CTL, 0, CTL_ZERO_BYTES, stream);
    Args a{};
    for (int i = 0; i < 20; ++i) a.in[i] = (const float*)d_in[i];
    a.out = out; a.ws = ws;
    int li = 0;
    mk_launch(a, 0, 14, li++, stream);
}
```
